# Optimizing an MI355X kernel written in HIP

```python
import math
import jax, jax.numpy as jnp
from jax import lax
import numpy as np

D_MODEL = 2048
BATCH = 8
SEQ = 2048
DEPTH = 2
DEC_BATCH = 16
DEC_SEQ = 64
PAST_LEN = 2048

CHUNK = 64
Q_BLOCK = 128
MLA_HEADS = 6
MLA_Q_RANK = 512
MLA_KV_RANK = 256
MLA_NOPE = 128
MLA_ROPE = 64
MLA_V = 128
ROPE_THETA = 10000.0
DIFF_HEADS = 4
DIFF_QK = 64
DIFF_V = 2 * DIFF_QK
BAND_HEADS = 6
BAND_DIM = 128
BAND_PREV_CHUNKS = 8
BAND_REL_CLIP = 256
T5_BUCKETS = 32
T5_MAX_DIST = 128
D_FF = 5632
CONV_W = 3
LN_EPS = 1e-5
RMS_EPS = 1e-6

IN_SIZES = (MLA_Q_RANK, MLA_KV_RANK, MLA_ROPE,
            DIFF_HEADS * 2 * DIFF_QK, DIFF_HEADS * 2 * DIFF_QK, DIFF_HEADS * DIFF_V,
            BAND_HEADS * BAND_DIM, BAND_HEADS * BAND_DIM, BAND_HEADS * BAND_DIM)
IN_COLS = sum(IN_SIZES)
MIX_WIDTH = MLA_HEADS * MLA_V + DIFF_HEADS * DIFF_V + BAND_HEADS * BAND_DIM
DEEPNORM_ALPHA = (2 * DEPTH) ** 0.25
DEEPNORM_BETA = (8 * DEPTH) ** -0.25

kernel_name = 'hybrid_streaming_encoder_step'


def layer_norm(x, g, b):
    xf = x.astype(jnp.float32)
    mu = jnp.mean(xf, -1, keepdims=True)
    var = jnp.mean(jnp.square(xf - mu), -1, keepdims=True)
    return ((xf - mu) * lax.rsqrt(var + LN_EPS) * g + b).astype(x.dtype)


def rms_norm(x, g):
    xf = x.astype(jnp.float32)
    return (xf * lax.rsqrt(jnp.mean(xf * xf, -1, keepdims=True) + RMS_EPS) * g).astype(x.dtype)


def rope(x, pos):
    half = x.shape[-1] // 2
    inv = ROPE_THETA ** (-jnp.arange(half, dtype=jnp.float32) / half)
    ang = pos.astype(jnp.float32)[:, None] * inv
    shape = (pos.shape[0],) + (1,) * (x.ndim - 3) + (half,)
    cos = jnp.cos(ang).reshape(shape)
    sin = jnp.sin(ang).reshape(shape)
    xf = x.astype(jnp.float32)
    x1, x2 = xf[..., :half], xf[..., half:]
    return jnp.concatenate([x1 * cos - x2 * sin, x1 * sin + x2 * cos], -1).astype(x.dtype)


def chunk_causal_mask(q_pos, k_pos):
    return (q_pos[:, None] // CHUNK) >= (k_pos[None, :] // CHUNK)


def t5_bucket(rel):
    half = T5_BUCKETS // 2
    exact = half // 2
    n = jnp.abs(rel)
    nf = jnp.maximum(n, 1).astype(jnp.float32)
    large = exact + (jnp.log(nf / exact) / math.log(T5_MAX_DIST / exact) * (half - exact)).astype(jnp.int32)
    large = jnp.minimum(large, half - 1)
    return jnp.where(rel > 0, half, 0) + jnp.where(n < exact, n, large)


def over_query_blocks(fn, q_pos, *qs):
    lq = q_pos.shape[0]
    if lq <= Q_BLOCK or lq % Q_BLOCK:
        return fn(q_pos, *qs)
    nb = lq // Q_BLOCK
    qp = q_pos.reshape(nb, Q_BLOCK)
    qb = [jnp.moveaxis(q.reshape((q.shape[0], nb, Q_BLOCK) + q.shape[2:]), 1, 0) for q in qs]
    out = lax.map(lambda a: fn(*a), (qp, *qb))
    out = jnp.moveaxis(out, 0, 1)
    return out.reshape((out.shape[0], lq) + out.shape[3:])


def mla_mixer(c_q, c_kv_raw, k_rope_raw, pos, past_ckv, past_krope, q_norm_g, w_uq, kv_norm_g, w_ukv):
    B, L, _ = c_q.shape
    q = (rms_norm(c_q, q_norm_g) @ w_uq).reshape(B, L, MLA_HEADS, MLA_NOPE + MLA_ROPE)
    q_nope = q[..., :MLA_NOPE]
    q_rope = rope(q[..., MLA_NOPE:], pos)
    ckv = rms_norm(c_kv_raw, kv_norm_g)
    krope = rope(k_rope_raw, pos)
    if past_ckv is None:
        ckv_all, krope_all, k_pos = ckv, krope, pos
    else:
        ckv_all = jnp.concatenate([past_ckv, ckv], 1)
        krope_all = jnp.concatenate([past_krope, krope], 1)
        k_pos = jnp.concatenate([jnp.arange(past_ckv.shape[1], dtype=jnp.int32), pos])
    lk = ckv_all.shape[1]
    kv = (ckv_all @ w_ukv).reshape(B, lk, MLA_HEADS, MLA_NOPE + MLA_V)
    k_nope, v = kv[..., :MLA_NOPE], kv[..., MLA_NOPE:]
    scale = (MLA_NOPE + MLA_ROPE) ** -0.5

    def attend(qp, qn, qr):
        s = (jnp.einsum('bqhd,bkhd->bhqk', qn, k_nope)
             + jnp.einsum('bqhr,bkr->bhqk', qr, krope_all)).astype(jnp.float32) * scale
        s = jnp.where(chunk_causal_mask(qp, k_pos), s, -jnp.inf)
        p = jax.nn.softmax(s, -1).astype(v.dtype)
        return jnp.einsum('bhqk,bkhd->bqhd', p, v)

    o = over_query_blocks(attend, pos, q_nope, q_rope)
    return o.reshape(B, L, MLA_HEADS * MLA_V), ckv, krope


def diff_mixer(d_q, d_k, d_v, pos, past_k, past_v, t5_table, lq1, lk1, lq2, lk2, subln_g, layer_idx):
    B, L, _ = d_q.shape
    q = d_q.reshape(B, L, DIFF_HEADS, 2, DIFF_QK)
    k_rows = d_k.reshape(B, L, DIFF_HEADS, 2 * DIFF_QK)
    v_rows = d_v.reshape(B, L, DIFF_HEADS, DIFF_V)
    if past_k is None:
        k_all, v_all, k_pos = k_rows, v_rows, pos
    else:
        k_all = jnp.concatenate([past_k, k_rows], 1)
        v_all = jnp.concatenate([past_v, v_rows], 1)
        k_pos = jnp.concatenate([jnp.arange(past_k.shape[1], dtype=jnp.int32), pos])
    lk = k_all.shape[1]
    k_all2 = k_all.reshape(B, lk, DIFF_HEADS, 2, DIFF_QK)
    lam_init = 0.8 - 0.6 * math.exp(-0.3 * layer_idx)
    lam = (jnp.exp(jnp.sum(lq1.astype(jnp.float32) * lk1.astype(jnp.float32)))
           - jnp.exp(jnp.sum(lq2.astype(jnp.float32) * lk2.astype(jnp.float32))) + lam_init)
    scale = DIFF_QK ** -0.5

    def attend(qp, qq):
        bias = t5_table[t5_bucket(k_pos[None, :] - qp[:, None])]
        bias = jnp.transpose(bias, (2, 0, 1)).astype(jnp.float32)
        s = jnp.einsum('bqhcd,bkhcd->bchqk', qq, k_all2).astype(jnp.float32) * scale + bias
        s = jnp.where(chunk_causal_mask(qp, k_pos), s, -jnp.inf)
        p = jax.nn.softmax(s, -1)
        a = p[:, 0] - lam * p[:, 1]
        return jnp.einsum('bhqk,bkhd->bqhd', a.astype(v_all.dtype), v_all)

    o = over_query_blocks(attend, pos, q)
    o = rms_norm(o, subln_g) * (1.0 - lam_init)
    return o.reshape(B, L, DIFF_HEADS * DIFF_V), k_rows, v_rows


def band_attend(q, k, v, q_pos, k_pos, rel_table):
    rel = jnp.clip(q_pos[:, :, None] - k_pos[:, None, :], -BAND_REL_CLIP, BAND_REL_CLIP) + BAND_REL_CLIP
    bias = jnp.transpose(rel_table[:, rel], (1, 0, 2, 3)).astype(jnp.float32)
    qc = (q_pos // CHUNK)[:, :, None]
    kc = (k_pos // CHUNK)[:, None, :]
    mask = (k_pos[:, None, :] >= 0) & (kc <= qc) & (kc >= qc - BAND_PREV_CHUNKS)
    s = jnp.einsum('bnqhd,bnkhd->bnhqk', q, k).astype(jnp.float32) * (BAND_DIM ** -0.5) + bias[None]
    s = jnp.where(mask[:, None], s, -jnp.inf)
    p = jax.nn.softmax(s, -1).astype(v.dtype)
    return jnp.einsum('bnhqk,bnkhd->bnqhd', p, v)


def band_mixer(b_q, b_k, b_v, pos, past_k, past_v, rel_table):
    B, L, _ = b_q.shape
    q = b_q.reshape(B, L, BAND_HEADS, BAND_DIM)
    k = b_k.reshape(B, L, BAND_HEADS, BAND_DIM)
    v = b_v.reshape(B, L, BAND_HEADS, BAND_DIM)
    band_rows = BAND_PREV_CHUNKS * CHUNK
    if past_k is None:
        nc = L // CHUNK
        idx = jnp.arange(nc)[:, None] + jnp.arange(BAND_PREV_CHUNKS + 1)[None, :]

        def gather_band(t):
            tc = t.reshape(B, nc, CHUNK, BAND_HEADS, BAND_DIM)
            tp = jnp.pad(tc, ((0, 0), (BAND_PREV_CHUNKS, 0), (0, 0), (0, 0), (0, 0)))
            return tp[:, idx].reshape(B, nc, (BAND_PREV_CHUNKS + 1) * CHUNK, BAND_HEADS, BAND_DIM)

        k_pos = (((idx - BAND_PREV_CHUNKS) * CHUNK)[:, :, None]
                 + jnp.arange(CHUNK, dtype=jnp.int32)[None, None, :]).reshape(nc, -1)
        o = band_attend(q.reshape(B, nc, CHUNK, BAND_HEADS, BAND_DIM), gather_band(k), gather_band(v),
                        pos.reshape(nc, CHUNK), k_pos, rel_table)
        keep = min(band_rows, L)
        new_k, new_v = k[:, L - keep:], v[:, L - keep:]
    else:
        w = past_k.shape[1]
        k_all = jnp.concatenate([past_k, k], 1)[:, None]
        v_all = jnp.concatenate([past_v, v], 1)[:, None]
        k_pos = jnp.concatenate([pos[0] - w + jnp.arange(w, dtype=jnp.int32), pos])[None]
        o = band_attend(q[:, None], k_all, v_all, pos[None], k_pos, rel_table)
        new_k, new_v = k, v
    return o.reshape(B, L, BAND_HEADS * BAND_DIM), new_k, new_v


def conv_ffn(x, prev, w_gate, w_up, conv_w, conv_b, w_down):
    B, L, _ = x.shape
    g = x @ w_gate
    u = x @ w_up
    if prev is None:
        prev = jnp.zeros((B, CONV_W - 1, D_FF), g.dtype)
    gp = jnp.concatenate([prev, g], 1)
    gc = conv_b + conv_w[0] * gp[:, 0:L]
    for j in range(1, CONV_W):
        gc = gc + conv_w[j] * gp[:, j:j + L]
    h = jax.nn.silu(gc) * u
    return h @ w_down, gp[:, L:]


def trunk_layer(x, pos, past, prm, l):
    if past is None:
        past = (None,) * 7
    p_ckv, p_krope, p_dk, p_dv, p_bk, p_bv, p_conv = past
    h = x @ prm['w_in'][l]
    offs = np.cumsum(IN_SIZES)[:-1].tolist()
    c_q, c_kv, k_rope, d_q, d_k, d_v, b_q, b_k, b_v = jnp.split(h, offs, axis=-1)
    o_a, ckv, krope = mla_mixer(c_q, c_kv, k_rope, pos, p_ckv, p_krope, prm['mla_q_norm'][l],
                                prm['mla_w_uq'][l], prm['mla_kv_norm'][l], prm['mla_w_ukv'][l])
    o_b, dk, dv = diff_mixer(d_q, d_k, d_v, pos, p_dk, p_dv, prm['t5_table'], prm['diff_lq1'][l],
                             prm['diff_lk1'][l], prm['diff_lq2'][l], prm['diff_lk2'][l],
                             prm['diff_subln'][l], l)
    o_c, bk, bv = band_mixer(b_q, b_k, b_v, pos, p_bk, p_bv, prm['band_rel_table'][l])
    mix = jnp.concatenate([o_a, o_b, o_c], -1) @ prm['w_o'][l]
    x = layer_norm(DEEPNORM_ALPHA * x + mix, prm['ln1_g'][l], prm['ln1_b'][l])
    f, conv_state = conv_ffn(x, p_conv, prm['ffn_w_gate'][l], prm['ffn_w_up'][l],
                             prm['ffn_conv_w'][l], prm['ffn_conv_b'][l], prm['ffn_w_down'][l])
    x = layer_norm(DEEPNORM_ALPHA * x + f, prm['ln2_g'][l], prm['ln2_b'][l])
    return x, (ckv, krope, dk, dv, bk, bv, conv_state)


def setup_inputs(seed: int = 0) -> dict:
    key = jax.random.key(seed)
    ks = jax.random.split(key, 32)
    nrm = lambda k, shape, s: jax.random.normal(k, shape, jnp.float32) * s
    cw = min(BAND_PREV_CHUNKS * CHUNK, PAST_LEN)
    return {
        'x_prompt': nrm(ks[0], (BATCH, SEQ, D_MODEL), 1.0),
        'x_sample': nrm(ks[1], (DEC_BATCH, DEC_SEQ, D_MODEL), 1.0),
        'cache_mla_ckv': nrm(ks[2], (DEPTH, DEC_BATCH, PAST_LEN, MLA_KV_RANK), 1.0),
        'cache_mla_krope': nrm(ks[3], (DEPTH, DEC_BATCH, PAST_LEN, MLA_ROPE), 1.0),
        'cache_diff_k': nrm(ks[4], (DEPTH, DEC_BATCH, PAST_LEN, DIFF_HEADS, 2 * DIFF_QK), 1.0),
        'cache_diff_v': nrm(ks[5], (DEPTH, DEC_BATCH, PAST_LEN, DIFF_HEADS, DIFF_V), 1.0),
        'cache_band_k': nrm(ks[6], (DEPTH, DEC_BATCH, cw, BAND_HEADS, BAND_DIM), 1.0),
        'cache_band_v': nrm(ks[7], (DEPTH, DEC_BATCH, cw, BAND_HEADS, BAND_DIM), 1.0),
        'state_ffn_conv': nrm(ks[8], (DEPTH, DEC_BATCH, CONV_W - 1, D_FF), 1.0),
        't5_table': nrm(ks[9], (T5_BUCKETS, DIFF_HEADS), 0.5),
        'w_in': nrm(ks[10], (DEPTH, D_MODEL, IN_COLS), D_MODEL ** -0.5),
        'mla_q_norm': 1.0 + nrm(ks[11], (DEPTH, MLA_Q_RANK), 0.02),
        'mla_w_uq': nrm(ks[12], (DEPTH, MLA_Q_RANK, MLA_HEADS * (MLA_NOPE + MLA_ROPE)), MLA_Q_RANK ** -0.5),
        'mla_kv_norm': 1.0 + nrm(ks[13], (DEPTH, MLA_KV_RANK), 0.02),
        'mla_w_ukv': nrm(ks[14], (DEPTH, MLA_KV_RANK, MLA_HEADS * (MLA_NOPE + MLA_V)), MLA_KV_RANK ** -0.5),
        'diff_lq1': nrm(ks[15], (DEPTH, DIFF_QK), 0.1),
        'diff_lk1': nrm(ks[16], (DEPTH, DIFF_QK), 0.1),
        'diff_lq2': nrm(ks[17], (DEPTH, DIFF_QK), 0.1),
        'diff_lk2': nrm(ks[18], (DEPTH, DIFF_QK), 0.1),
        'diff_subln': 1.0 + nrm(ks[19], (DEPTH, DIFF_V), 0.02),
        'band_rel_table': nrm(ks[20], (DEPTH, BAND_HEADS, 2 * BAND_REL_CLIP + 1), 0.5),
        'w_o': nrm(ks[21], (DEPTH, MIX_WIDTH, D_MODEL), MIX_WIDTH ** -0.5 * DEEPNORM_BETA),
        'ln1_g': 1.0 + nrm(ks[22], (DEPTH, D_MODEL), 0.02),
        'ln1_b': nrm(ks[23], (DEPTH, D_MODEL), 0.02),
        'ffn_w_gate': nrm(ks[24], (DEPTH, D_MODEL, D_FF), D_MODEL ** -0.5),
        'ffn_w_up': nrm(ks[25], (DEPTH, D_MODEL, D_FF), D_MODEL ** -0.5 * DEEPNORM_BETA),
        'ffn_conv_w': nrm(ks[26], (DEPTH, CONV_W, D_FF), CONV_W ** -0.5),
        'ffn_conv_b': nrm(ks[27], (DEPTH, D_FF), 0.01),
        'ffn_w_down': nrm(ks[28], (DEPTH, D_FF, D_MODEL), D_FF ** -0.5 * DEEPNORM_BETA),
        'ln2_g': 1.0 + nrm(ks[29], (DEPTH, D_MODEL), 0.02),
        'ln2_b': nrm(ks[30], (DEPTH, D_MODEL), 0.02),
    }


def reference(x_prompt, x_sample, cache_mla_ckv, cache_mla_krope, cache_diff_k, cache_diff_v,
              cache_band_k, cache_band_v, state_ffn_conv, t5_table, w_in, mla_q_norm, mla_w_uq,
              mla_kv_norm, mla_w_ukv, diff_lq1, diff_lk1, diff_lq2, diff_lk2, diff_subln,
              band_rel_table, w_o, ln1_g, ln1_b, ffn_w_gate, ffn_w_up, ffn_conv_w, ffn_conv_b,
              ffn_w_down, ln2_g, ln2_b):
    prm = {'t5_table': t5_table, 'w_in': w_in, 'mla_q_norm': mla_q_norm, 'mla_w_uq': mla_w_uq,
           'mla_kv_norm': mla_kv_norm, 'mla_w_ukv': mla_w_ukv, 'diff_lq1': diff_lq1,
           'diff_lk1': diff_lk1, 'diff_lq2': diff_lq2, 'diff_lk2': diff_lk2,
           'diff_subln': diff_subln, 'band_rel_table': band_rel_table, 'w_o': w_o,
           'ln1_g': ln1_g, 'ln1_b': ln1_b, 'ffn_w_gate': ffn_w_gate, 'ffn_w_up': ffn_w_up,
           'ffn_conv_w': ffn_conv_w, 'ffn_conv_b': ffn_conv_b, 'ffn_w_down': ffn_w_down,
           'ln2_g': ln2_g, 'ln2_b': ln2_b}
    past_len = cache_mla_ckv.shape[2]
    pos_p = jnp.arange(x_prompt.shape[1], dtype=jnp.int32)
    pos_s = past_len + jnp.arange(x_sample.shape[1], dtype=jnp.int32)
    y_prompt, y_sample = x_prompt, x_sample
    states_p, states_s = [], []
    for l in range(DEPTH):
        y_prompt, st_p = trunk_layer(y_prompt, pos_p, None, prm, l)
        past = (cache_mla_ckv[l], cache_mla_krope[l], cache_diff_k[l], cache_diff_v[l],
                cache_band_k[l], cache_band_v[l], state_ffn_conv[l])
        y_sample, st_s = trunk_layer(y_sample, pos_s, past, prm, l)
        states_p.append(st_p)
        states_s.append(st_s)
    p_ckv, p_krope, p_dk, p_dv, p_bk, p_bv, p_conv = [jnp.stack(t) for t in zip(*states_p)]
    s_ckv, s_krope, s_dk, s_dv, s_bk, s_bv, s_conv = [jnp.stack(t) for t in zip(*states_s)]
    return (y_prompt, y_sample, p_ckv, p_krope, p_dk, p_dv, p_bk, p_bv, p_conv,
            s_ckv, s_krope, s_dk, s_dv, s_bk, s_bv, s_conv)
```

```cpp
#include <hip/hip_runtime.h>
#include <hip/hip_cooperative_groups.h>
#include <cstdio>
#include <cstdint>
namespace cg = cooperative_groups;

#define LAS __attribute__((address_space(3)))
typedef unsigned short bf16_t;
typedef short bf16x8 __attribute__((ext_vector_type(8)));
typedef float f32x4 __attribute__((ext_vector_type(4)));
typedef float f32x16 __attribute__((ext_vector_type(16)));
typedef unsigned u32x4 __attribute__((ext_vector_type(4)));
typedef unsigned u32x2 __attribute__((ext_vector_type(2)));

constexpr int DM = 2048, NBP = 8, SEQ = 2048, NBS = 16, DSEQ = 64, PAST = 2048;
constexpr int MP = NBP * SEQ, MS = NBS * DSEQ, MT = MP + MS;
constexpr int SKV = PAST + DSEQ;
constexpr int MKV = MP + NBS * SKV;
constexpr int NIN = 4864, RAWW = 1024, HWD = 3840, DFF = 5632, NQ = 1280, NKVC = 1536;
constexpr int BKS = 576;
constexpr float LOG2E = 1.4426950408889634f;
constexpr float ALPHA = 1.4142135623730951f;

constexpr size_t O_Y = 0;
constexpr size_t O_PCKV = (size_t)MT * DM;
constexpr size_t O_PKR = O_PCKV + 2ull * 8 * 2048 * 256;
constexpr size_t O_PDK = O_PKR + 2ull * 8 * 2048 * 64;
constexpr size_t O_PDV = O_PDK + 2ull * 8 * 2048 * 512;
constexpr size_t O_PBK = O_PDV + 2ull * 8 * 2048 * 512;
constexpr size_t O_PBV = O_PBK + 2ull * 8 * 512 * 768;
constexpr size_t O_PCONV = O_PBV + 2ull * 8 * 512 * 768;
constexpr size_t O_SCKV = O_PCONV + 2ull * 8 * 2 * DFF;
constexpr size_t O_SKR = O_SCKV + 2ull * 16 * 64 * 256;
constexpr size_t O_SDK = O_SKR + 2ull * 16 * 64 * 64;
constexpr size_t O_SDV = O_SDK + 2ull * 16 * 64 * 512;
constexpr size_t O_SBK = O_SDV + 2ull * 16 * 64 * 512;
constexpr size_t O_SBV = O_SBK + 2ull * 16 * 64 * 768;
constexpr size_t O_SCONV = O_SBV + 2ull * 16 * 64 * 768;
constexpr size_t O_END = O_SCONV + 2ull * 16 * 2 * DFF;

constexpr size_t al256(size_t x) { return (x + 255) & ~(size_t)255; }
constexpr size_t WS_CTL = 0;
constexpr size_t WS_BAR = 16384;
constexpr size_t CTL_BYTES = 65536;
constexpr size_t WS_LAM = 65536;
constexpr size_t WS_ROPE = 65536 + 4096;
constexpr size_t WS_T5 = al256(WS_ROPE + (size_t)SKV * 64 * 4);
constexpr int T5N = 2176, T5OFF = 2111;
constexpr size_t WS_STATS = al256(WS_T5 + 4ull * T5N * 4);
constexpr size_t WS_WIN = al256(WS_STATS + (size_t)MT * 8);
constexpr size_t WS_WUQ = WS_WIN + (size_t)NIN * DM * 2;
constexpr size_t WS_WUKV = WS_WUQ + (size_t)NQ * 512 * 2;
constexpr size_t WS_WO = WS_WUKV + (size_t)NKVC * 256 * 2;
constexpr size_t WS_WGU = WS_WO + (size_t)DM * DM * 2;
constexpr size_t WS_WD = WS_WGU + 2ull * DFF * DM * 2;
constexpr size_t WS_XB = WS_WD + (size_t)DM * DFF * 2;
constexpr size_t WS_XF = WS_XB + (size_t)MT * DM * 2;
constexpr size_t WS_C0 = WS_XF + (size_t)MT * DM * 4;
constexpr size_t WS_RAW = WS_C0;
constexpr size_t WS_H = WS_RAW + (size_t)MT * RAWW * 4;
constexpr size_t WS_Z = WS_XF;
constexpr size_t WS_SLAB = WS_C0 + (32u << 20);
constexpr size_t WS_GH = WS_C0;
constexpr size_t WS_UH = WS_C0 + (16u << 20);
constexpr size_t WS_C1 = WS_H + (size_t)MT * HWD * 2;
constexpr size_t WS_Q = WS_C1;
constexpr size_t WS_KV = WS_Q + (size_t)MT * NQ * 2;
constexpr size_t WS_U = WS_C1;
constexpr size_t WS_C2 = WS_KV + (size_t)MKV * NKVC * 2;
constexpr size_t WS_O = WS_C2;
constexpr size_t WS_CKVA = WS_O + (size_t)MT * DM * 2;
constexpr size_t WS_KR = WS_CKVA + (size_t)MKV * 256 * 2;
constexpr size_t WS_CQN = WS_KR + (size_t)MKV * 64 * 2;
constexpr size_t WS_DKS = WS_CQN + (size_t)MT * 512 * 2;
constexpr size_t WS_DVS = WS_DKS + (size_t)NBS * SKV * 512 * 2;
constexpr size_t WS_BKS = WS_DVS + (size_t)NBS * SKV * 512 * 2;
constexpr size_t WS_BVS = WS_BKS + (size_t)NBS * BKS * 768 * 2;
constexpr size_t WS_END = WS_BVS + (size_t)NBS * BKS * 768 * 2;
static_assert((size_t)MT * DFF * 2 <= WS_C2 - WS_C1, "U fits C1");
static_assert((32u << 20) + 7ull * MS * DM * 4 <= WS_C1 - WS_C0, "split-K slabs fit C0");

constexpr int LDS_BYTES = 147456;

__device__ __forceinline__ unsigned pk2(float lo, float hi) {
    typedef float f2 __attribute__((ext_vector_type(2))); typedef __bf16 b2 __attribute__((ext_vector_type(2)));
    f2 v = {lo, hi}; b2 b = __builtin_convertvector(v, b2); return __builtin_bit_cast(unsigned, b);
}
__device__ __forceinline__ float bflo(unsigned u) { return __uint_as_float(u << 16); }
__device__ __forceinline__ float bfhi(unsigned u) { return __uint_as_float(u & 0xffff0000u); }
__device__ __forceinline__ float wave_sum(float v) {
#pragma unroll
    for (int o = 1; o < 64; o <<= 1) v += __shfl_xor(v, o);
    return v;
}
__device__ __forceinline__ int opq(int v) { asm volatile("" : "+v"(v)); return v; }
__device__ __forceinline__ int opqs(int v) { v = __builtin_amdgcn_readfirstlane(v); asm volatile("" : "+s"(v)); return v; }
__device__ __forceinline__ int opss(int v) { asm volatile("" : "+s"(v)); return v; }
__device__ __forceinline__ int crow(int r, int hi) { return (r & 3) + 8 * (r >> 2) + 4 * hi; }

namespace pg8 {
constexpr int BM = 256, BK = 64, HALF = 128, HTB = HALF * BK * 2, STAGE_BYTES = 8 * HTB, NXCD = 8, WGM = 8;
__host__ __device__ __forceinline__ int lds_byte(int r, int c) { const int st = (r >> 4) * 2 + (c >> 5), rr = r & 15, cc = c & 31, ob = rr * 64 + cc * 2; return st * 1024 + (ob ^ (((ob >> 9) & 1) << 5)); }
__host__ __device__ __forceinline__ void stage_rc(int b, int& R, int& C) { const int st = b / 1024, sb = b % 1024, swz = sb ^ (((sb >> 9) & 1) << 5); R = (st >> 1) * 16 + swz / 64; C = (st & 1) * 32 + (swz % 64) / 2; }
__host__ __device__ __forceinline__ int perm32(int rho) { const int n = rho >> 4, i = rho & 15; return 8 * (i >> 2) + 4 * n + (i & 3); }

struct Unit { int pm, pn, koff, nt; };
struct Gemm { const bf16_t* A; const bf16_t* Bt; int M, N, K; };

struct StaticOrder {
    int nM, nN, nwg, G, c, nt0;
    __device__ void init(int M, int N, int K, int G_, int c_) { nM = M / BM; nN = N / BM; nwg = nM * nN; G = G_; c = c_; nt0 = K / BK; }
    __device__ bool next(int i, Unit& u) const { const long L = (long)i * G + c; if (L >= nwg) return false; at((int)L, u); return true; }
    __device__ void at(int wgid, Unit& u) const {
        { const int q = nwg / NXCD, r = nwg % NXCD, xcd = wgid % NXCD, off = wgid / NXCD; wgid = (xcd < r ? xcd * (q + 1) : r * (q + 1) + (xcd - r) * q) + off; }
        const int nig = WGM * nN, gid = wgid / nig, fm = gid * WGM, gsz = (nM - fm) < WGM ? (nM - fm) : WGM;
        u.pm = fm + ((wgid % nig) % gsz); u.pn = (wgid % nig) / gsz; u.koff = 0; u.nt = nt0;
    }
    __device__ __forceinline__ void a_ready(const Unit&) const {}
    __device__ __forceinline__ void done(const Unit&) const {}
};


struct TailOrder {
    StaticOrder so; int K;
    __device__ void init(int K_, int G_, int c_) { so.init(MP, DM, K_, G_, c_); K = K_; }
    __device__ bool next(int i, Unit& u) const {
        const long L = (long)i * so.G + so.c;
        if (L < so.nwg) { so.at((int)L, u); return true; }
        const long j = L - so.nwg; if (j >= 256) return false;
        const int ks = (int)(j & 7), tile = (int)(j >> 3); u.pm = 64 + (tile >> 3); u.pn = tile & 7;
        if (K == DM) { u.koff = ks * 256; u.nt = 4; }
        else { u.koff = 64 * (22 * (ks >> 1) + ((ks & 1) ? 12 : 0)); u.nt = (ks & 1) ? 10 : 12; }
        return true;
    }
    __device__ __forceinline__ void a_ready(const Unit&) const {}
    __device__ __forceinline__ void done(const Unit&) const {}
};

template <class Epi, class Sched, bool ALIGN_EPI = false, bool SP2 = false>
__device__ __forceinline__ void gemm_phase(LAS unsigned char* lds, const Gemm g, const Sched& S, const Epi& E) {
    const int tid = opq(threadIdx.x), wid = __builtin_amdgcn_readfirstlane(tid >> 6), lane = tid & 63, wr = wid >> 2, wc = wid & 3, fr = lane & 15, fq = lane >> 4;
    const int K = g.K;
    unsigned voffA[2], voffB[2];
#pragma unroll
    for (int i = 0; i < 2; ++i) { int R, C; stage_rc(tid * 16 + i * 8192, R, C); const int Rb = Epi::PERM ? ((R & ~31) + perm32(R & 31)) : R;
        voffA[i] = (unsigned)(R * K + C) * 2u; voffB[i] = (unsigned)(Rb * K + C) * 2u; }
    const size_t kstep = (size_t)(BK * 2);
    const size_t hstep = (size_t)HALF * K * 2;
    const size_t tstep = 2 * hstep;
    const unsigned ldsw = (unsigned)wid * 1024u;
    const int aoff = lds_byte(wr * 64 + fr, fq * 8), boff = lds_byte(wc * 32 + fr, fq * 8);
#define PG8_SA(b, h) (((b) * 2 + (h)) * HTB)
#define PG8_SB(b, h) ((4 + (b) * 2 + (h)) * HTB)
#define PG8_STAGE(bufoff, gbase, voff) do { _Pragma("unroll") for (int _i = 0; _i < 2; ++_i) \
        __builtin_amdgcn_global_load_lds((const unsigned*)((const char*)(gbase) + (voff)[_i]), (LAS unsigned*)(lds + (bufoff) + ldsw + _i * 8192), 16, 0, 0); } while (0)
#define PG8_LDA(dst, b, h) do { _Pragma("unroll") for (int m = 0; m < 4; ++m) _Pragma("unroll") for (int k = 0; k < 2; ++k) dst[m][k] = *(const LAS bf16x8*)(lds + PG8_SA(b, h) + aoff + m * 2048 + k * 1024); } while (0)
#define PG8_LDB(dst, b, h) do { _Pragma("unroll") for (int n = 0; n < 2; ++n) _Pragma("unroll") for (int k = 0; k < 2; ++k) dst[n][k] = *(const LAS bf16x8*)(lds + PG8_SB(b, h) + boff + n * 2048 + k * 1024); } while (0)
#define PG8_MMA(ai, bj, At, Bt) do { __builtin_amdgcn_s_setprio(1); _Pragma("unroll") for (int m = 0; m < 4; ++m) _Pragma("unroll") for (int n = 0; n < 2; ++n) _Pragma("unroll") for (int k = 0; k < 2; ++k) \
        acc[ai][bj][m][n] = __builtin_amdgcn_mfma_f32_16x16x32_bf16(Bt[n][k], At[m][k], acc[ai][bj][m][n], 0, 0, 0); __builtin_amdgcn_s_setprio(0); } while (0)
#define PG8_WAIT_V(n) asm volatile("s_waitcnt vmcnt(" #n ")" ::: "memory")
#define PG8_WAIT_L(n) asm volatile("s_waitcnt lgkmcnt(" #n ")" ::: "memory")
#define PG8_BAR __builtin_amdgcn_s_barrier()
#define PG8_SCHED __builtin_amdgcn_sched_barrier(0)
    Unit cur, nxt; int ui = 0;
    if (!S.next(0, cur)) return;
    f32x4 acc[2][2][4][2];
#pragma unroll
    for (int a = 0; a < 2; ++a)
#pragma unroll
        for (int b = 0; b < 2; ++b)
#pragma unroll
            for (int m = 0; m < 4; ++m)
#pragma unroll
                for (int n = 0; n < 2; ++n) acc[a][b][m][n] = (f32x4){0.f, 0.f, 0.f, 0.f};
    bf16x8 At[4][2], B0[2][2], B1[2][2];
    const char* cA = (const char*)g.A + (size_t)cur.pm * tstep + (size_t)cur.koff * 2; const char* cB = (const char*)g.Bt + (size_t)cur.pn * tstep + (size_t)cur.koff * 2;
    S.a_ready(cur);
    if constexpr (SP2) {
        PG8_STAGE(PG8_SB(0, 0), cB, voffB); PG8_STAGE(PG8_SB(0, 1), cB + hstep, voffB); PG8_STAGE(PG8_SA(0, 0), cA, voffA); PG8_STAGE(PG8_SA(0, 1), cA + hstep, voffA);
        if (wr == 1) PG8_BAR;
        PG8_WAIT_V(2); PG8_BAR;
        PG8_STAGE(PG8_SB(1, 0), cB + kstep, voffB); PG8_STAGE(PG8_SA(1, 0), cA + kstep, voffA); PG8_STAGE(PG8_SB(1, 1), cB + hstep + kstep, voffB);
        PG8_WAIT_V(6); PG8_BAR;
    } else {
        PG8_STAGE(PG8_SB(0, 0), cB, voffB); PG8_STAGE(PG8_SA(0, 0), cA, voffA); PG8_STAGE(PG8_SB(0, 1), cB + hstep, voffB); PG8_STAGE(PG8_SA(0, 1), cA + hstep, voffA);
        if (wr == 1) PG8_BAR;
        PG8_WAIT_V(4); PG8_BAR;
        PG8_STAGE(PG8_SB(1, 0), cB + kstep, voffB); PG8_STAGE(PG8_SA(1, 0), cA + kstep, voffA); PG8_STAGE(PG8_SB(1, 1), cB + hstep + kstep, voffB);
        PG8_WAIT_V(6); PG8_BAR;
    }
    for (;;) {
        const bool has_next = S.next(ui + 1, nxt);
        const char* nA = has_next ? (const char*)g.A + (size_t)nxt.pm * tstep + (size_t)nxt.koff * 2 : cA; const char* nB = has_next ? (const char*)g.Bt + (size_t)nxt.pn * tstep + (size_t)nxt.koff * 2 : cB;
        const int nt = cur.nt;
        for (int t = 0; t < nt; t += 2) {
            const bool last = (t == nt - 2);
            const char* a1 = cA + (size_t)(t + 1) * kstep;
            const char* a2 = last ? nA : cA + (size_t)(t + 2) * kstep; const char* b2 = last ? nB : cB + (size_t)(t + 2) * kstep;
            const char* a3 = a2 + kstep; const char* b3 = b2 + kstep;
            if (last && has_next) S.a_ready(nxt);
            if constexpr (SP2) {
            PG8_LDB(B0, 0, 0); PG8_LDB(B1, 0, 1); PG8_SCHED; PG8_LDA(At, 0, 0); PG8_STAGE(PG8_SA(1, 1), a1 + hstep, voffA);
            PG8_WAIT_V(8); PG8_WAIT_L(0); PG8_BAR; PG8_MMA(0, 0, At, B0); PG8_MMA(0, 1, At, B1); PG8_BAR; PG8_SCHED;
            PG8_LDA(At, 0, 1); PG8_STAGE(PG8_SB(0, 0), b2, voffB); PG8_STAGE(PG8_SB(0, 1), b2 + hstep, voffB); PG8_STAGE(PG8_SA(0, 0), a2, voffA);
            PG8_WAIT_V(8); PG8_WAIT_L(0); PG8_BAR; PG8_MMA(1, 0, At, B0); PG8_MMA(1, 1, At, B1); PG8_BAR; PG8_SCHED;
            PG8_LDB(B0, 1, 0); PG8_LDB(B1, 1, 1); PG8_SCHED; PG8_LDA(At, 1, 0); PG8_STAGE(PG8_SA(0, 1), a2 + hstep, voffA);
            PG8_WAIT_V(8); PG8_WAIT_L(0); PG8_BAR; PG8_MMA(0, 0, At, B0); PG8_MMA(0, 1, At, B1); PG8_BAR; PG8_SCHED;
            PG8_LDA(At, 1, 1); PG8_STAGE(PG8_SB(1, 0), b3, voffB); PG8_STAGE(PG8_SB(1, 1), b3 + hstep, voffB); PG8_STAGE(PG8_SA(1, 0), a3, voffA);
            PG8_WAIT_V(8); PG8_WAIT_L(0); PG8_BAR; PG8_MMA(1, 0, At, B0); PG8_MMA(1, 1, At, B1); PG8_BAR; PG8_SCHED;
            } else {
            PG8_LDB(B0, 0, 0); PG8_SCHED; PG8_LDA(At, 0, 0); PG8_STAGE(PG8_SA(1, 1), a1 + hstep, voffA);
            PG8_WAIT_L(8); PG8_BAR; PG8_WAIT_L(0); PG8_MMA(0, 0, At, B0); PG8_BAR; PG8_SCHED;
            PG8_LDB(B1, 0, 1); PG8_STAGE(PG8_SB(0, 0), b2, voffB);
            PG8_BAR; PG8_WAIT_L(0); PG8_MMA(0, 1, At, B1); PG8_BAR;
            PG8_LDA(At, 0, 1); PG8_STAGE(PG8_SA(0, 0), a2, voffA);
            PG8_BAR; PG8_WAIT_L(0); PG8_MMA(1, 0, At, B0); PG8_BAR; PG8_SCHED;
            PG8_STAGE(PG8_SB(0, 1), b2 + hstep, voffB);
            PG8_WAIT_V(6); PG8_BAR; PG8_MMA(1, 1, At, B1); PG8_BAR;
            PG8_LDB(B0, 1, 0); PG8_SCHED; PG8_LDA(At, 1, 0); PG8_STAGE(PG8_SA(0, 1), a2 + hstep, voffA);
            PG8_WAIT_L(8); PG8_BAR; PG8_WAIT_L(0); PG8_MMA(0, 0, At, B0); PG8_BAR; PG8_SCHED;
            PG8_LDB(B1, 1, 1); PG8_STAGE(PG8_SB(1, 0), b3, voffB);
            PG8_BAR; PG8_WAIT_L(0); PG8_MMA(0, 1, At, B1); PG8_BAR;
            PG8_LDA(At, 1, 1); PG8_STAGE(PG8_SA(1, 0), a3, voffA);
            PG8_BAR; PG8_WAIT_L(0); PG8_MMA(1, 0, At, B0); PG8_BAR; PG8_SCHED;
            PG8_STAGE(PG8_SB(1, 1), b3 + hstep, voffB);
            PG8_WAIT_V(6); PG8_BAR; PG8_MMA(1, 1, At, B1); PG8_BAR;
            }
        }
        if constexpr (ALIGN_EPI) { if (wr == 0) PG8_BAR; }
        E(acc, cur, wr, wc, fr, fq); S.done(cur);
        if (!has_next) break;
#pragma unroll
        for (int a = 0; a < 2; ++a)
#pragma unroll
            for (int b = 0; b < 2; ++b)
#pragma unroll
                for (int m = 0; m < 4; ++m)
#pragma unroll
                    for (int n = 0; n < 2; ++n) acc[a][b][m][n] = (f32x4){0.f, 0.f, 0.f, 0.f};
        cur = nxt; cA = nA; cB = nB; ++ui;
        if constexpr (ALIGN_EPI) { if (wr == 1) PG8_BAR; }
    }
    PG8_WAIT_V(0);
    if constexpr (!ALIGN_EPI) { if (wr == 0) PG8_BAR; }
    PG8_BAR;
#undef PG8_SA
#undef PG8_SB
#undef PG8_STAGE
#undef PG8_LDA
#undef PG8_LDB
#undef PG8_MMA
#undef PG8_WAIT_V
#undef PG8_WAIT_L
#undef PG8_BAR
#undef PG8_SCHED
}
}

typedef const f32x4 (&AccRef)[2][2][4][2];

__device__ __forceinline__ u32x4 pack8(const f32x4 a, const f32x4 b) {
    u32x4 w; w.x = pk2(a[0], a[1]); w.y = pk2(a[2], a[3]); w.z = pk2(b[0], b[1]); w.w = pk2(b[2], b[3]); return w;
}
struct EpiIn {
    static constexpr bool PERM = true;
    float* raw; bf16_t* H; float* out; int l;
    __device__ __forceinline__ void operator()(AccRef acc, const pg8::Unit& u, int wr, int wc, int fr, int fq) const {
        const int pn = u.pn, lr0 = wr * 64 + fr, ct = wc * 32 + 8 * fq;
        const size_t grow0 = (size_t)u.pm * 256;
        if (pn < 4) {
#pragma unroll
            for (int ai = 0; ai < 2; ++ai)
#pragma unroll
                for (int m = 0; m < 4; ++m) { float* rp = raw + (grow0 + lr0 + ai * 128 + m * 16) * RAWW + pn * 256 + ct;
#pragma unroll
                    for (int bj = 0; bj < 2; ++bj) { *(f32x4*)(rp + bj * 128) = acc[ai][bj][m][0]; *(f32x4*)(rp + bj * 128 + 4) = acc[ai][bj][m][1]; } }
            return;
        }
        float* sb = nullptr; int sp = 0; int rsub = 0;
        const bool prompt = u.pm < 64;
        const size_t lrow = prompt ? ((size_t)l * MP + grow0) : ((size_t)l * MS + (grow0 - MP));
        if (pn == 6 || pn == 7) { sb = out + (prompt ? O_PDK : O_SDK) + lrow * 512 + (pn - 6) * 256; sp = 512; }
        else if (pn == 8 || pn == 9) { sb = out + (prompt ? O_PDV : O_SDV) + lrow * 512 + (pn - 8) * 256; sp = 512; }
        else if (pn >= 13) {
            const int g = pn >= 16 ? 1 : 0, gc = (pn - (g ? 16 : 13)) * 256;
            if (prompt) { if ((u.pm & 7) >= 6) { const size_t r = (size_t)(l * 8 + (u.pm >> 3)) * 512 + ((u.pm & 7) - 6) * 256; sb = out + (g ? O_PBV : O_PBK) + r * 768 + gc; sp = 768; } }
            else { sb = out + (g ? O_SBV : O_SBK) + lrow * 768 + gc; sp = 768; }
        }
        (void)rsub;
        const int hc = (pn - 4) * 256 + ct;
#pragma unroll
        for (int ai = 0; ai < 2; ++ai)
#pragma unroll
            for (int m = 0; m < 4; ++m) { const int lr = lr0 + ai * 128 + m * 16; bf16_t* hp = H + (grow0 + lr) * HWD + hc;
#pragma unroll
                for (int bj = 0; bj < 2; ++bj) { *(u32x4*)(hp + bj * 128) = pack8(acc[ai][bj][m][0], acc[ai][bj][m][1]);
                    if (sb) { float* p = sb + (size_t)lr * sp + bj * 128 + ct; *(f32x4*)p = acc[ai][bj][m][0]; *(f32x4*)(p + 4) = acc[ai][bj][m][1]; } } }
    }
};
struct EpiBf {
    static constexpr bool PERM = true;
    bf16_t* O; int ldc;
    __device__ __forceinline__ void operator()(AccRef acc, const pg8::Unit& u, int wr, int wc, int fr, int fq) const {
        const int ct = u.pn * 256 + wc * 32 + 8 * fq; const size_t row0 = (size_t)u.pm * 256 + wr * 64 + fr;
#pragma unroll
        for (int ai = 0; ai < 2; ++ai)
#pragma unroll
            for (int m = 0; m < 4; ++m) { bf16_t* rp = O + (row0 + ai * 128 + m * 16) * ldc + ct;
#pragma unroll
                for (int bj = 0; bj < 2; ++bj) *(u32x4*)(rp + bj * 128) = pack8(acc[ai][bj][m][0], acc[ai][bj][m][1]); }
    }
};
struct EpiRes {
    static constexpr bool PERM = true;
    float* Z; float* slab; const float* resP; const float* resS; const float* stats; const float* gam; const float* bet; int K;
    __device__ __forceinline__ void operator()(AccRef acc, const pg8::Unit& u, int wr, int wc, int fr, int fq) const {
        const int ct = u.pn * 256 + wc * 32 + 8 * fq; const size_t row0 = (size_t)u.pm * 256 + wr * 64 + fr;
        if (u.koff != 0) {
            const int ks = (K == DM) ? (u.koff >> 8) : (2 * (u.koff / (64 * 22)) + ((u.koff / 64) % 22 != 0 ? 1 : 0));
            float* sl = slab + (size_t)(ks - 1) * MS * DM - (size_t)MP * DM;
#pragma unroll
            for (int ai = 0; ai < 2; ++ai)
#pragma unroll
                for (int m = 0; m < 4; ++m) { const size_t off = (row0 + ai * 128 + m * 16) * DM + ct;
#pragma unroll
                    for (int bj = 0; bj < 2; ++bj) { *(f32x4*)(sl + off + bj * 128) = acc[ai][bj][m][0]; *(f32x4*)(sl + off + bj * 128 + 4) = acc[ai][bj][m][1]; } }
            return;
        }
        if (resP) {
            const float* rb = (u.pm < 64) ? resP : (resS - (size_t)MP * DM);
#pragma unroll
            for (int ai = 0; ai < 2; ++ai)
#pragma unroll
                for (int m = 0; m < 4; ++m) { const size_t off = (row0 + ai * 128 + m * 16) * DM + ct;
#pragma unroll
                    for (int bj = 0; bj < 2; ++bj) { const f32x4 r0 = *(const f32x4*)(rb + off + bj * 128), r1 = *(const f32x4*)(rb + off + bj * 128 + 4);
                        *(f32x4*)(Z + off + bj * 128) = r0 * ALPHA + acc[ai][bj][m][0]; *(f32x4*)(Z + off + bj * 128 + 4) = r1 * ALPHA + acc[ai][bj][m][1]; } }
            return;
        }
        f32x4 g0[2], g1[2], b0[2], b1[2];
#pragma unroll
        for (int bj = 0; bj < 2; ++bj) { g0[bj] = *(const f32x4*)(gam + ct + bj * 128) * ALPHA; g1[bj] = *(const f32x4*)(gam + ct + bj * 128 + 4) * ALPHA;
            b0[bj] = *(const f32x4*)(bet + ct + bj * 128) * ALPHA; b1[bj] = *(const f32x4*)(bet + ct + bj * 128 + 4) * ALPHA; }
#pragma unroll
        for (int ai = 0; ai < 2; ++ai)
#pragma unroll
            for (int m = 0; m < 4; ++m) { const size_t r = row0 + ai * 128 + m * 16; const size_t off = r * DM + ct;
                const float mu = stats[2 * r], rs = stats[2 * r + 1];
#pragma unroll
                for (int bj = 0; bj < 2; ++bj) { const f32x4 z0 = *(const f32x4*)(Z + off + bj * 128), z1 = *(const f32x4*)(Z + off + bj * 128 + 4);
                    *(f32x4*)(Z + off + bj * 128) = ((z0 - mu) * rs) * g0[bj] + b0[bj] + acc[ai][bj][m][0];
                    *(f32x4*)(Z + off + bj * 128 + 4) = ((z1 - mu) * rs) * g1[bj] + b1[bj] + acc[ai][bj][m][1]; } }
    }
};
template <int CTRL> __device__ __forceinline__ float dppf(float old, float src) {
    return __int_as_float(__builtin_amdgcn_update_dpp(__float_as_int(old), __float_as_int(src), CTRL, 0xf, 0xf, false));
}
__device__ __forceinline__ float silu_f(float x) { return x * __builtin_amdgcn_rcpf(1.f + __builtin_amdgcn_exp2f(-x * LOG2E)); }
struct EpiGU {
    static constexpr bool PERM = true;
    bf16_t* Hh; bf16_t* GH; bf16_t* UH; const float* cw; const float* cb;
    __device__ __forceinline__ void operator()(AccRef acc, const pg8::Unit& u, int wr, int wc, int fr, int fq) const {
        const int ffc = u.pn * 128 + wc * 32 + 8 * fq;
        float w0[8], w1[8], w2[8], bb[8];
        { const f32x4 a0 = *(const f32x4*)(cw + ffc), a1 = *(const f32x4*)(cw + ffc + 4), b0 = *(const f32x4*)(cw + DFF + ffc), b1 = *(const f32x4*)(cw + DFF + ffc + 4),
                      c0 = *(const f32x4*)(cw + 2 * DFF + ffc), c1 = *(const f32x4*)(cw + 2 * DFF + ffc + 4), d0 = *(const f32x4*)(cb + ffc), d1 = *(const f32x4*)(cb + ffc + 4);
#pragma unroll
          for (int e = 0; e < 4; ++e) { w0[e] = a0[e]; w0[4 + e] = a1[e]; w1[e] = b0[e]; w1[4 + e] = b1[e]; w2[e] = c0[e]; w2[4 + e] = c1[e]; bb[e] = d0[e]; bb[4 + e] = d1[e]; } }
#pragma unroll
        for (int ai = 0; ai < 2; ++ai) {
            const int slab = u.pm * 4 + ai * 2 + wr;
            float gp[8];
#pragma unroll
            for (int e = 0; e < 8; ++e) gp[e] = 0.f;
#pragma unroll
            for (int m = 0; m < 4; ++m) {
                float g[8], uu[8], h[8];
#pragma unroll
                for (int e = 0; e < 4; ++e) { g[e] = acc[ai][0][m][0][e]; g[4 + e] = acc[ai][0][m][1][e]; uu[e] = acc[ai][1][m][0][e]; uu[4 + e] = acc[ai][1][m][1][e]; }
#pragma unroll
                for (int e = 0; e < 8; ++e) {
                    const float p1 = dppf<0x111>(dppf<0x121>(0.f, gp[e]), g[e]);
                    const float p2 = dppf<0x112>(dppf<0x122>(0.f, gp[e]), g[e]);
                    h[e] = silu_f(bb[e] + w0[e] * p2 + w1[e] * p1 + w2[e] * g[e]) * uu[e];
                    gp[e] = g[e];
                }
                const int lr = m * 16 + fr; const size_t row = (size_t)slab * 64 + lr;
                u32x4 o; o.x = pk2(h[0], h[1]); o.y = pk2(h[2], h[3]); o.z = pk2(h[4], h[5]); o.w = pk2(h[6], h[7]);
                *(u32x4*)(Hh + row * DFF + ffc) = o;
                if (m == 0 || m == 3) {
                    u32x4 gb; gb.x = pk2(g[0], g[1]); gb.y = pk2(g[2], g[3]); gb.z = pk2(g[4], g[5]); gb.w = pk2(g[6], g[7]);
                    if (m == 3 && fr >= 14) *(u32x4*)(GH + ((size_t)slab * 4 + (fr - 14)) * DFF + ffc) = gb;
                    if (m == 0 && fr < 2) { *(u32x4*)(GH + ((size_t)slab * 4 + 2 + fr) * DFF + ffc) = gb;
                        u32x4 ub; ub.x = pk2(uu[0], uu[1]); ub.y = pk2(uu[2], uu[3]); ub.z = pk2(uu[4], uu[5]); ub.w = pk2(uu[6], uu[7]);
                        *(u32x4*)(UH + ((size_t)slab * 2 + fr) * DFF + ffc) = ub; }
                }
            }
        }
    }
};

struct Params { const float* in[31]; float* out; unsigned char* ws; };
typedef const __attribute__((address_space(4))) Params* KP;
__device__ __forceinline__ KP kparams() { KP k = (KP)__builtin_amdgcn_kernarg_segment_ptr(); asm volatile("" : "+s"(k)); return k; }
enum { I_XP = 0, I_XS, I_CCKV, I_CKR, I_CDK, I_CDV, I_CBK, I_CBV, I_CONV, I_T5, I_WIN, I_QN, I_WUQ, I_KVN, I_WUKV, I_LQ1, I_LK1, I_LQ2, I_LK2, I_SUBLN,
       I_BREL, I_WO, I_LN1G, I_LN1B, I_WG, I_WU, I_CW, I_CB, I_WD, I_LN2G, I_LN2B };

__device__ __forceinline__ void tconv(LAS unsigned char* lds, const float* W, int K, int Nsrc, bf16_t* Wt, int ndst, int map, const float* W2 = nullptr) {
    LAS float* tile = (LAS float*)lds;
    const int tid = opq(threadIdx.x), nbn = ndst / 256, nitems = nbn * (K / 64);
    const int nn = tid & 255, k2 = tid >> 8;
    float v[32];
    auto load_item = [&](int item) {
        const int nb = item % nbn, kb = item / nbn, dn = nb * 256 + nn;
        int sc = dn;
        if (map == 1) sc = dn < 832 ? dn : (dn < 1024 ? -1 : dn - 192);
        else if (map == 2) sc = dn < Nsrc ? dn : -1;
        else if (map == 3) sc = nb * 128 + (nn & 127);
        const float* wp = ((map == 3 && nn >= 128) ? W2 : W) + (size_t)(kb * 64 + k2) * Nsrc + (sc >= 0 ? sc : 0);
#pragma unroll
        for (int i = 0; i < 32; ++i) v[i] = sc >= 0 ? wp[(size_t)(2 * i) * Nsrc] : 0.f;
    };
    int item = blockIdx.x;
    if (item < nitems) load_item(item);
    for (; item < nitems; item += gridDim.x) {
        const int nb = item % nbn, kb = item / nbn, n0 = nb * 256;
#pragma unroll
        for (int i = 0; i < 32; ++i) tile[(k2 + 2 * i) * 257 + nn] = v[i];
        __syncthreads();
        if (item + (int)gridDim.x < nitems) load_item(item + gridDim.x);
        const int kc = tid & 7;
#pragma unroll
        for (int j = 0; j < 4; ++j) { const int n = (tid >> 3) + 64 * j; const LAS float* s = tile + (kc * 8) * 257 + n;
            u32x4 o; o.x = pk2(s[0], s[257]); o.y = pk2(s[2 * 257], s[3 * 257]); o.z = pk2(s[4 * 257], s[5 * 257]); o.w = pk2(s[6 * 257], s[7 * 257]);
            *(u32x4*)(Wt + (size_t)(n0 + n) * K + kb * 64 + kc * 8) = o; }
        __syncthreads();
    }
}
__device__ __forceinline__ void convert_weights(LAS unsigned char* lds, KP p, int l) {
    unsigned char* ws = p->ws;
    tconv(lds, p->in[I_WIN] + (size_t)l * DM * 4672, DM, 4672, (bf16_t*)(ws + WS_WIN), NIN, 1);
    tconv(lds, p->in[I_WUQ] + (size_t)l * 512 * 1152, 512, 1152, (bf16_t*)(ws + WS_WUQ), NQ, 2);
    tconv(lds, p->in[I_WUKV] + (size_t)l * 256 * 1536, 256, 1536, (bf16_t*)(ws + WS_WUKV), NKVC, 0);
    tconv(lds, p->in[I_WO] + (size_t)l * DM * DM, DM, DM, (bf16_t*)(ws + WS_WO), DM, 0);
    tconv(lds, p->in[I_WG] + (size_t)l * DM * DFF, DM, DFF, (bf16_t*)(ws + WS_WGU), 2 * DFF, 3, p->in[I_WU] + (size_t)l * DM * DFF);
    tconv(lds, p->in[I_WD] + (size_t)l * DFF * DM, DFF, DM, (bf16_t*)(ws + WS_WD), DM, 0);
}
__device__ __forceinline__ void cvt_rows(const float* src, bf16_t* dst, int nb, int rpb, int w, int drpb) {
    const int w8 = w >> 3; const long total = (long)nb * rpb * w8; const long gt = (long)blockIdx.x * 512 + opq(threadIdx.x), gn = (long)gridDim.x * 512;
    for (long ch0 = gt; ch0 < total; ch0 += 4 * gn) {
        f32x4 a[4], c[4]; size_t doff[4]; bool ok[4];
#pragma unroll
        for (int u = 0; u < 4; ++u) { const long ch = ch0 + u * gn; ok[u] = ch < total; const long chc = ok[u] ? ch : ch0;
            const int cc = (int)(chc % w8); const long rj = chc / w8; const int b = (int)(rj / rpb), j = (int)(rj % rpb);
            a[u] = *(const f32x4*)(src + rj * w + cc * 8); c[u] = *(const f32x4*)(src + rj * w + cc * 8 + 4); doff[u] = ((size_t)b * drpb + j) * w + cc * 8; }
#pragma unroll
        for (int u = 0; u < 4; ++u) if (ok[u]) *(u32x4*)(dst + doff[u]) = pack8(a[u], c[u]);
    }
}
__device__ __forceinline__ int t5_bucket(int rel) {
    const int n = rel < 0 ? -rel : rel; int b;
    if (n < 8) b = n; else if (n < 12) b = 8; else if (n < 16) b = 9; else if (n < 23) b = 10; else if (n < 32) b = 11; else if (n < 46) b = 12; else if (n < 64) b = 13; else if (n < 91) b = 14; else b = 15;
    return (rel > 0 ? 16 : 0) + b;
}
__device__ __forceinline__ void prologue(LAS unsigned char* lds, KP p) {
    unsigned char* ws = p->ws;
    convert_weights(lds, p, 0);
    cvt_rows(p->in[I_XP], (bf16_t*)(ws + WS_XB), 1, MP, DM, MP);
    cvt_rows(p->in[I_XS], (bf16_t*)(ws + WS_XB) + (size_t)MP * DM, 1, MS, DM, MS);
    const long gt = (long)blockIdx.x * 512 + opq(threadIdx.x), gn = (long)gridDim.x * 512;
    float* rope = (float*)(ws + WS_ROPE);
    for (long i = gt; i < (long)SKV * 32; i += gn) { const int pos = (int)(i >> 5), j = (int)(i & 31);
        const float inv = powf(10000.0f, -(float)j / 32.0f); const float ang = (float)pos * inv; float s, c; sincosf(ang, &s, &c);
        rope[pos * 64 + j] = c; rope[pos * 64 + 32 + j] = s; }
    float* t5 = (float*)(ws + WS_T5);
    for (long i = gt; i < 4L * T5N; i += gn) { const int h = (int)(i / T5N), idx = (int)(i % T5N); const int rel = idx - T5OFF;
        t5[i] = p->in[I_T5][t5_bucket(rel) * 4 + h] * LOG2E; }
    if (blockIdx.x == 0 && threadIdx.x < 128) {
        const int l = threadIdx.x >> 6, j = threadIdx.x & 63;
        const float a = wave_sum(p->in[I_LQ1][l * 64 + j] * p->in[I_LK1][l * 64 + j]), b = wave_sum(p->in[I_LQ2][l * 64 + j] * p->in[I_LK2][l * 64 + j]);
        if (j == 0) ((float*)(ws + WS_LAM))[l] = expf(a) - expf(b) + (0.8f - 0.6f * expf(-0.3f * (float)l));
    }
}

__device__ __forceinline__ void post_in_phase(KP p, int l) {
    unsigned char* ws = p->ws;
    const int tidq = opq(threadIdx.x); const int lane = tidq & 63, gw = blockIdx.x * 8 + (tidq >> 6), ngw = gridDim.x * 8;
    const float* raw = (const float*)(ws + WS_RAW); const bf16_t* H = (const bf16_t*)(ws + WS_H);
    bf16_t* cqn = (bf16_t*)(ws + WS_CQN); bf16_t* ckva = (bf16_t*)(ws + WS_CKVA); bf16_t* kr = (bf16_t*)(ws + WS_KR);
    const float* rope = (const float*)(ws + WS_ROPE);
    const float* qg = p->in[I_QN] + l * 512; const float* kg = p->in[I_KVN] + l * 256;
    for (int r = gw; r < MT; r += ngw) {
        const float* rr = raw + (size_t)r * RAWW;
        const bool prompt = r < MP; const int rs = r - MP, b = rs >> 6, t = rs & 63;
        const size_t arow = prompt ? (size_t)r : (size_t)MP + (size_t)b * SKV + PAST + t;
        const int pos = prompt ? (r & (SEQ - 1)) : PAST + t;
        {
            const f32x4 a = *(const f32x4*)(rr + lane * 8), c = *(const f32x4*)(rr + lane * 8 + 4);
            float ss = a[0] * a[0] + a[1] * a[1] + a[2] * a[2] + a[3] * a[3] + c[0] * c[0] + c[1] * c[1] + c[2] * c[2] + c[3] * c[3];
            ss = wave_sum(ss); const float rs_ = rsqrtf(ss * (1.f / 512.f) + 1e-6f);
            const f32x4 g0 = *(const f32x4*)(qg + lane * 8), g1 = *(const f32x4*)(qg + lane * 8 + 4);
            *(u32x4*)(cqn + (size_t)r * 512 + lane * 8) = pack8(a * rs_ * g0, c * rs_ * g1);
        }
        {
            const f32x4 a = *(const f32x4*)(rr + 512 + lane * 4);
            float ss = wave_sum(a[0] * a[0] + a[1] * a[1] + a[2] * a[2] + a[3] * a[3]); const float rs_ = rsqrtf(ss * (1.f / 256.f) + 1e-6f);
            const f32x4 g0 = *(const f32x4*)(kg + lane * 4); const f32x4 v = a * rs_ * g0;
            float* op = prompt ? p->out + O_PCKV + ((size_t)l * MP + r) * 256 : p->out + O_SCKV + ((size_t)l * MS + rs) * 256;
            *(f32x4*)(op + lane * 4) = v;
            u32x2 w; w.x = pk2(v[0], v[1]); w.y = pk2(v[2], v[3]); *(u32x2*)(ckva + arow * 256 + lane * 4) = w;
        }
        if (lane < 32) {
            const float x1 = rr[768 + lane], x2 = rr[768 + 32 + lane]; const float c = rope[pos * 64 + lane], s = rope[pos * 64 + 32 + lane];
            const float y1 = x1 * c - x2 * s, y2 = x1 * s + x2 * c;
            float* op = prompt ? p->out + O_PKR + ((size_t)l * MP + r) * 64 : p->out + O_SKR + ((size_t)l * MS + rs) * 64;
            op[lane] = y1; op[32 + lane] = y2;
            kr[arow * 64 + lane] = (bf16_t)(pk2(y1, 0.f) & 0xffffu); kr[arow * 64 + 32 + lane] = (bf16_t)(pk2(y2, 0.f) & 0xffffu);
        }
    }
}

__device__ __forceinline__ void cvt_queue(LAS unsigned char* lds, KP p, int l) {
    unsigned char* ws = p->ws; const int tid = opq(threadIdx.x);
    unsigned* ctr = (unsigned*)(ws + WS_CTL) + 1024 + 64 * l;
    volatile LAS int* slot = (volatile LAS int*)(lds + 131072 + 512);
    for (;;) {
        if (tid == 0) slot[0] = (int)atomicAdd(ctr, 1u);
        __syncthreads();
        int c = slot[0];
        __syncthreads();
        if (c >= 640) break;
        const float* src; bf16_t* dst; int rpb, w, drpb;
        if (c < 512) { src = p->in[I_CCKV] + (size_t)l * NBS * PAST * 256; dst = (bf16_t*)(ws + WS_CKVA) + (size_t)MP * 256; rpb = PAST; w = 256; drpb = SKV; }
        else { c -= 512; src = p->in[I_CKR] + (size_t)l * NBS * PAST * 64; dst = (bf16_t*)(ws + WS_KR) + (size_t)MP * 64; rpb = PAST; w = 64; drpb = SKV; }
        const int w8 = w >> 3;
        f32x4 a[4], d[4]; size_t doff[4];
#pragma unroll
        for (int u = 0; u < 4; ++u) { const long ch = (long)c * 2048 + u * 512 + tid; const int cc = (int)(ch % w8); const long rj = ch / w8; const int b = (int)(rj / rpb), j = (int)(rj % rpb);
            a[u] = *(const f32x4*)(src + rj * w + cc * 8); d[u] = *(const f32x4*)(src + rj * w + cc * 8 + 4); doff[u] = ((size_t)b * drpb + j) * w + cc * 8; }
#pragma unroll
        for (int u = 0; u < 4; ++u) *(u32x4*)(dst + doff[u]) = pack8(a[u], d[u]);
    }
}

__device__ __forceinline__ void ln_load_row(float* Z, const float* slab, int r, int lane, f32x4 (&v)[8]) {
    float* zr = Z + (size_t)r * DM;
#pragma unroll
    for (int j = 0; j < 8; ++j) v[j] = *(const f32x4*)(zr + j * 256 + lane * 4);
    if (r >= MP) {
#pragma unroll 1
        for (int ks = 1; ks < 8; ++ks) { const float* sr = slab + ((size_t)(ks - 1) * MS + (r - MP)) * DM;
#pragma unroll
            for (int j = 0; j < 8; ++j) v[j] += *(const f32x4*)(sr + j * 256 + lane * 4); }
#pragma unroll
        for (int j = 0; j < 8; ++j) *(f32x4*)(zr + j * 256 + lane * 4) = v[j];
    }
}
__device__ __forceinline__ void ln_finish_row(int r, int lane, f32x4 (&v)[8], const float* g, const float* bta, float* stats, float* yout, bf16_t* xb) {
    float s = 0.f;
#pragma unroll
    for (int j = 0; j < 8; ++j) s += (v[j][0] + v[j][1]) + (v[j][2] + v[j][3]);
    const float mean = wave_sum(s) * (1.f / DM); float q = 0.f;
#pragma unroll
    for (int j = 0; j < 8; ++j) { v[j] = v[j] - mean; q += (v[j][0] * v[j][0] + v[j][1] * v[j][1]) + (v[j][2] * v[j][2] + v[j][3] * v[j][3]); }
    const float rstd = rsqrtf(wave_sum(q) * (1.f / DM) + 1e-5f);
    if (lane == 0) { stats[2 * r] = mean; stats[2 * r + 1] = rstd; }
#pragma unroll
    for (int j = 0; j < 8; ++j) { const int c = j * 256 + lane * 4; const f32x4 gg = *(const f32x4*)(g + c), bb = *(const f32x4*)(bta + c);
        const f32x4 y = v[j] * rstd * gg + bb; if (yout) *(f32x4*)(yout + (size_t)r * DM + c) = y;
        u32x2 w; w.x = pk2(y[0], y[1]); w.y = pk2(y[2], y[3]); *(u32x2*)(xb + (size_t)r * DM + c) = w; }
}
__device__ __forceinline__ void ln_phase(float* Z, const float* slab, const float* g, const float* bta, float* stats, float* yout, bf16_t* xb) {
    const int tidq = opq(threadIdx.x); const int lane = tidq & 63, gw = blockIdx.x * 8 + (tidq >> 6), ngw = gridDim.x * 8;
    f32x4 va[8], vb[8];
    int r = gw;
    if (r < MT) ln_load_row(Z, slab, r, lane, va);
    for (; r < MT; r += 2 * ngw) {
        const int r1 = r + ngw, r2 = r + 2 * ngw;
        if (r1 < MT) ln_load_row(Z, slab, r1, lane, vb);
        ln_finish_row(r, lane, va, g, bta, stats, yout, xb);
        if (r2 < MT) ln_load_row(Z, slab, r2, lane, va);
        if (r1 < MT) ln_finish_row(r1, lane, vb, g, bta, stats, yout, xb);
    }
}

__device__ __forceinline__ void unpack8(const u32x4 v, float (&f)[8]) {
#pragma unroll
    for (int e = 0; e < 4; ++e) { f[2 * e] = bflo(v[e]); f[2 * e + 1] = bfhi(v[e]); }
}
__device__ __forceinline__ void fixup_phase(KP p, int l) {
    unsigned char* ws = p->ws; bf16_t* Hh = (bf16_t*)(ws + WS_U); const bf16_t* GH = (const bf16_t*)(ws + WS_GH); const bf16_t* UH = (const bf16_t*)(ws + WS_UH);
    const float* cw = p->in[I_CW] + (size_t)l * 3 * DFF; const float* cb = p->in[I_CB] + (size_t)l * DFF; const float* st = p->in[I_CONV] + (size_t)l * NBS * 2 * DFF;
    constexpr int NCH = DFF / 8, NSLAB = MT / 64; const long total = (long)NSLAB * NCH; const long gt = (long)blockIdx.x * 512 + opq(threadIdx.x), gn = (long)gridDim.x * 512;
    for (long it = gt; it < total; it += gn) {
        const int cc = (int)(it % NCH), s = (int)(it / NCH), c0 = cc * 8; const bool prompt = s < MP / 64;
        float w0[8], w1[8], w2[8], bb[8], gm2[8], gm1[8], g0[8], g1[8], u0[8], u1[8], g62[8], g63[8];
#pragma unroll
        for (int e = 0; e < 8; ++e) { w0[e] = cw[c0 + e]; w1[e] = cw[DFF + c0 + e]; w2[e] = cw[2 * DFF + c0 + e]; bb[e] = cb[c0 + e]; }
        const bool first = prompt ? ((s & 31) == 0) : true;
        if (first) {
            if (prompt) {
#pragma unroll
                for (int e = 0; e < 8; ++e) { gm2[e] = 0.f; gm1[e] = 0.f; }
            } else { const int b = s - MP / 64;
#pragma unroll
                for (int e = 0; e < 8; ++e) { gm2[e] = st[((size_t)b * 2 + 0) * DFF + c0 + e]; gm1[e] = st[((size_t)b * 2 + 1) * DFF + c0 + e]; } }
        } else { unpack8(*(const u32x4*)(GH + ((size_t)(s - 1) * 4 + 0) * DFF + c0), gm2); unpack8(*(const u32x4*)(GH + ((size_t)(s - 1) * 4 + 1) * DFF + c0), gm1); }
        unpack8(*(const u32x4*)(GH + ((size_t)s * 4 + 2) * DFF + c0), g0); unpack8(*(const u32x4*)(GH + ((size_t)s * 4 + 3) * DFF + c0), g1);
        unpack8(*(const u32x4*)(UH + ((size_t)s * 2 + 0) * DFF + c0), u0); unpack8(*(const u32x4*)(UH + ((size_t)s * 2 + 1) * DFF + c0), u1);
        float h0[8], h1[8];
#pragma unroll
        for (int e = 0; e < 8; ++e) { h0[e] = silu_f(bb[e] + w0[e] * gm2[e] + w1[e] * gm1[e] + w2[e] * g0[e]) * u0[e]; h1[e] = silu_f(bb[e] + w0[e] * gm1[e] + w1[e] * g0[e] + w2[e] * g1[e]) * u1[e]; }
        u32x4 o; o.x = pk2(h0[0], h0[1]); o.y = pk2(h0[2], h0[3]); o.z = pk2(h0[4], h0[5]); o.w = pk2(h0[6], h0[7]);
        *(u32x4*)(Hh + (size_t)s * 64 * DFF + c0) = o;
        o.x = pk2(h1[0], h1[1]); o.y = pk2(h1[2], h1[3]); o.z = pk2(h1[4], h1[5]); o.w = pk2(h1[6], h1[7]);
        *(u32x4*)(Hh + ((size_t)s * 64 + 1) * DFF + c0) = o;
        const bool last = prompt ? ((s & 31) == 31) : true;
        if (last) {
            unpack8(*(const u32x4*)(GH + ((size_t)s * 4 + 0) * DFF + c0), g62); unpack8(*(const u32x4*)(GH + ((size_t)s * 4 + 1) * DFF + c0), g63);
            float* sp = prompt ? p->out + O_PCONV + ((size_t)(l * 8 + (s >> 5)) * 2) * DFF + c0 : p->out + O_SCONV + ((size_t)(l * 16 + (s - MP / 64)) * 2) * DFF + c0;
            *(f32x4*)sp = (f32x4){g62[0], g62[1], g62[2], g62[3]}; *(f32x4*)(sp + 4) = (f32x4){g62[4], g62[5], g62[6], g62[7]};
            *(f32x4*)(sp + DFF) = (f32x4){g63[0], g63[1], g63[2], g63[3]}; *(f32x4*)(sp + DFF + 4) = (f32x4){g63[4], g63[5], g63[6], g63[7]};
        }
    }
}

#define MFMA32(a, b, c) __builtin_amdgcn_mfma_f32_32x32x16_bf16((a), (b), (c), 0, 0, 0)
constexpr int A_VSTR = 144, A_VBUF = 128 * A_VSTR;
constexpr int A_KVEND = 2 * 64 * (192 + 8) * 2 + 2 * A_VBUF;
constexpr int A_STASH = 2 * 64 * (64 + 8) * 2 + 2 * A_VBUF;
constexpr int A_BIAS = A_STASH + 65536, A_WSF = 131072 + 2048, A_UIDX = 131072 + 1024;
static_assert(A_KVEND <= A_BIAS && A_BIAS + T5N * 4 <= 131072 && A_WSF + 8 * 64 * 4 <= LDS_BYTES, "attention LDS");

struct AttnSrc {
    const bf16_t* K; int kpitch;
    const bf16_t* K2; int k2pitch;
    const bf16_t* V; int vpitch;
    int t0, t1;
    int lo_t, hi_t;
    bool wave_on;
    float scale2;
    int bias_base;
    const float* Kf; const float* Kf2; const float* Vf; const float* Vf2; int ntc;
    int qmin, kpos0;
};

template <int DQK, int BIAS, bool F32 = false>
__device__ __forceinline__ void attn_pass(LAS unsigned char* lds, const AttnSrc& a, const bf16x8 (&qf)[DQK / 16], f32x16 (&o)[4]) {
    constexpr int KSTR = (DQK + 8) * 2, NKCH = DQK / 8, NKI = DQK / 64, A_K0 = 0, A_K1 = 64 * KSTR, A_V0 = 2 * A_K1, A_V1 = A_V0 + A_VBUF;
    const int tid = opq(threadIdx.x), lane = tid & 63, r32 = lane & 31, hi = lane >> 5, wid = tid >> 6;
    const LAS float* bt = (const LAS float*)(lds + A_BIAS);
    volatile LAS float* wsf = (volatile LAS float*)(lds + A_WSF) + wid * 64;
    u32x4 kreg[F32 ? 1 : NKI]; u32x2 vreg[F32 ? 1 : 4];
    f32x4 kraw[F32 ? NKI : 1][2], vraw[F32 ? 4 : 1];
    const int vdq = tid & 31, vkq = tid >> 5;
    auto load_tile = [&](int t) {
        if constexpr (F32) {
            const float* kb_ = (t < a.ntc) ? a.Kf + (size_t)t * 64 * a.kpitch : a.Kf2; const float* vb_ = (t < a.ntc) ? a.Vf + (size_t)t * 64 * a.vpitch : a.Vf2;
#pragma unroll
            for (int i = 0; i < NKI; ++i) { const int c = tid + 512 * i, row = c / NKCH, cc = c % NKCH; const float* s_ = kb_ + (size_t)row * a.kpitch + cc * 8;
                kraw[i][0] = *(const f32x4*)s_; kraw[i][1] = *(const f32x4*)(s_ + 4); }
#pragma unroll
            for (int i = 0; i < 4; ++i) vraw[i] = *(const f32x4*)(vb_ + (size_t)(vkq * 4 + i) * a.vpitch + vdq * 4);
        } else {
            const size_t krow0 = (size_t)t * 64;
#pragma unroll
            for (int i = 0; i < NKI; ++i) { const int c = tid + 512 * i, row = c / NKCH, cc = c % NKCH;
                const bf16_t* src = (DQK == 192 && cc >= 16) ? a.K2 + (krow0 + row) * a.k2pitch + (cc - 16) * 8 : a.K + (krow0 + row) * a.kpitch + cc * 8;
                kreg[i] = *(const u32x4*)src; }
#pragma unroll
            for (int i = 0; i < 4; ++i) vreg[i] = *(const u32x2*)(a.V + (krow0 + vkq * 4 + i) * a.vpitch + vdq * 4);
        }
    };
    auto store_tile = [&](int buf) {
        LAS unsigned char* kb = lds + (buf ? A_K1 : A_K0); LAS unsigned char* vb = lds + (buf ? A_V1 : A_V0);
        u32x2 v0, v1, v2, v3;
        if constexpr (F32) {
#pragma unroll
            for (int i = 0; i < NKI; ++i) { const int c = tid + 512 * i, row = c / NKCH, cc = c % NKCH; *(LAS u32x4*)(kb + row * KSTR + cc * 16) = pack8(kraw[i][0], kraw[i][1]); }
            v0.x = pk2(vraw[0][0], vraw[0][1]); v0.y = pk2(vraw[0][2], vraw[0][3]); v1.x = pk2(vraw[1][0], vraw[1][1]); v1.y = pk2(vraw[1][2], vraw[1][3]);
            v2.x = pk2(vraw[2][0], vraw[2][1]); v2.y = pk2(vraw[2][2], vraw[2][3]); v3.x = pk2(vraw[3][0], vraw[3][1]); v3.y = pk2(vraw[3][2], vraw[3][3]);
        } else {
#pragma unroll
            for (int i = 0; i < NKI; ++i) { const int c = tid + 512 * i, row = c / NKCH, cc = c % NKCH; *(LAS u32x4*)(kb + row * KSTR + cc * 16) = kreg[i]; }
            v0 = vreg[0]; v1 = vreg[1]; v2 = vreg[2]; v3 = vreg[3];
        }
        u32x2 w0, w1, w2, w3;
        w0.x = (v0.x & 0xffffu) | (v1.x << 16); w0.y = (v2.x & 0xffffu) | (v3.x << 16);
        w1.x = (v0.x >> 16) | (v1.x & 0xffff0000u); w1.y = (v2.x >> 16) | (v3.x & 0xffff0000u);
        w2.x = (v0.y & 0xffffu) | (v1.y << 16); w2.y = (v2.y & 0xffffu) | (v3.y << 16);
        w3.x = (v0.y >> 16) | (v1.y & 0xffff0000u); w3.y = (v2.y >> 16) | (v3.y & 0xffff0000u);
        LAS unsigned char* vp = vb + (vdq * 4) * A_VSTR + (vkq >> 2) * 32 + ((vkq & 1) * 16 + ((vkq >> 1) & 1) * 8);
        *(LAS u32x2*)(vp) = w0; *(LAS u32x2*)(vp + A_VSTR) = w1; *(LAS u32x2*)(vp + 2 * A_VSTR) = w2; *(LAS u32x2*)(vp + 3 * A_VSTR) = w3;
    };
    float m = -1e30f, l = 0.f;
#pragma unroll
    for (int d = 0; d < 4; ++d)
#pragma unroll
        for (int r = 0; r < 16; ++r) o[d][r] = 0.f;
    load_tile(a.t0); store_tile(0); __syncthreads();
    for (int t = a.t0; t < a.t1; ++t) {
        const int buf = (t - a.t0) & 1;
        if (t + 1 < a.t1) load_tile(t + 1);
        if (a.wave_on && t >= a.lo_t && t <= a.hi_t) {
#pragma unroll 1
            for (int half = 0; half < 2; ++half) {
                const LAS unsigned char* kb = lds + (buf ? A_K1 : A_K0) + (half * 32 + r32) * KSTR + hi * 16;
                f32x16 p0;
#pragma unroll
                for (int r = 0; r < 16; ++r) p0[r] = 0.f;
                constexpr int NF = DQK / 16, NBT = NF / 4;
                {
                    bf16x8 kf[2][4];
#pragma unroll
                    for (int j = 0; j < 4; ++j) kf[0][j] = *(const LAS bf16x8*)(kb + j * 32);
#pragma unroll
                    for (int bt = 0; bt < NBT; ++bt) {
                        if (bt + 1 < NBT) {
#pragma unroll
                            for (int j = 0; j < 4; ++j) kf[(bt + 1) & 1][j] = *(const LAS bf16x8*)(kb + ((bt + 1) * 4 + j) * 32);
                        }
                        __builtin_amdgcn_sched_barrier(0);
#pragma unroll
                        for (int j = 0; j < 4; ++j) p0 = MFMA32(kf[bt & 1][j], qf[bt * 4 + j], p0);
                        __builtin_amdgcn_sched_barrier(0);
                    }
                }
                const LAS unsigned char* vb = lds + (buf ? A_V1 : A_V0) + r32 * A_VSTR + hi * 16 + half * 64;
                u32x4 vf[4][2];
#define RDV(d, ks) vf[d][ks] = *(const LAS u32x4*)(vb + (d) * 32 * A_VSTR + (ks) * 32)
                if (DQK != 192) { RDV(0, 0); RDV(0, 1); }
                __builtin_amdgcn_sched_barrier(0);
                float mx = -1e30f;
                if (BIAS == 0) {
#pragma unroll
                    for (int r = 0; r < 16; ++r) { p0[r] *= a.scale2; mx = fmaxf(mx, p0[r]); }
                } else if (BIAS == 1) {
                    if (a.kpos0 + 64 * t + 63 <= a.qmin - 128) {
                        const float cbias = bt[T5OFF - 128];
#pragma unroll
                        for (int r = 0; r < 16; ++r) { p0[r] = p0[r] * a.scale2 + cbias; mx = fmaxf(mx, p0[r]); }
                    } else {
                        const LAS float* bp = bt + (a.bias_base + 64 * t + 32 * half);
#pragma unroll
                        for (int r = 0; r < 16; ++r) { const int ko = (r & 3) + 8 * (r >> 2); p0[r] = p0[r] * a.scale2 + bp[ko]; mx = fmaxf(mx, p0[r]); }
                    }
                } else {
                    if (a.qmin - (a.kpos0 + 64 * t + 63) >= 256) {
                        const float cbias = bt[512];
#pragma unroll
                        for (int r = 0; r < 16; ++r) { p0[r] = p0[r] * a.scale2 + cbias; mx = fmaxf(mx, p0[r]); }
                    } else {
                        const int jb = a.bias_base - 64 * t - 32 * half;
#pragma unroll
                        for (int r = 0; r < 16; ++r) { const int ko = (r & 3) + 8 * (r >> 2); const int i0 = min(jb - ko, 256) + 256;
                            p0[r] = p0[r] * a.scale2 + bt[i0]; mx = fmaxf(mx, p0[r]); }
                    }
                }
                mx = fmaxf(mx, __shfl_xor(mx, 32));
                const bool grow = mx > m + 8.0f;
                if (__any(grow)) {
                    const float mnew = grow ? mx : m, alpha = __builtin_amdgcn_exp2f(m - mnew); m = mnew; l *= alpha;
                    if (hi == 0) wsf[r32] = alpha;
#pragma unroll
                    for (int r = 0; r < 16; ++r) { const float f = wsf[crow(r, hi)];
#pragma unroll
                        for (int d = 0; d < 4; ++d) o[d][r] *= f; }
                }
                float rs = 0.f;
#pragma unroll
                for (int r = 0; r < 16; ++r) { p0[r] = __builtin_amdgcn_exp2f(p0[r] - m); rs += p0[r]; }
                l += rs;
                bf16x8 pa[2];
                { u32x4 w;
                  w.x = pk2(p0[0], p0[1]); w.y = pk2(p0[2], p0[3]); w.z = pk2(p0[4], p0[5]); w.w = pk2(p0[6], p0[7]); pa[0] = __builtin_bit_cast(bf16x8, w);
                  w.x = pk2(p0[8], p0[9]); w.y = pk2(p0[10], p0[11]); w.z = pk2(p0[12], p0[13]); w.w = pk2(p0[14], p0[15]); pa[1] = __builtin_bit_cast(bf16x8, w); }
                if (DQK == 192) { RDV(0, 0); RDV(0, 1); }
                RDV(1, 0); RDV(1, 1); RDV(2, 0); RDV(2, 1); RDV(3, 0); RDV(3, 1);
                __builtin_amdgcn_sched_barrier(0);
#pragma unroll
                for (int d = 0; d < 4; ++d)
#pragma unroll
                    for (int ks = 0; ks < 2; ++ks) o[d] = MFMA32(pa[ks], __builtin_bit_cast(bf16x8, vf[d][ks]), o[d]);
#undef RDV
            }
        }
        if (t + 1 < a.t1) store_tile(buf ^ 1);
        __syncthreads();
    }
    if (a.wave_on) {
        l += __shfl_xor(l, 32);
        if (hi == 0) wsf[r32] = 1.0f / l;
#pragma unroll
        for (int r = 0; r < 16; ++r) { const float f = wsf[crow(r, hi)];
#pragma unroll
            for (int d = 0; d < 4; ++d) o[d][r] *= f; }
    }
}

template <int NF>
__device__ __forceinline__ void load_q(bf16x8 (&qf)[NF], const bf16_t* qrow  ) {
#pragma unroll
    for (int d0 = 0; d0 < NF; ++d0) qf[d0] = *(const bf16x8*)(qrow + d0 * 16);
}
__device__ __forceinline__ void store_o(LAS unsigned char* stg, bf16_t* op  , const f32x16 (&o)[4], int lane) {
    const int r32 = lane & 31, hi = lane >> 5;
    LAS unsigned short* s = (LAS unsigned short*)stg + (4 * hi) * 128 + r32;
#pragma unroll
    for (int d = 0; d < 4; ++d)
#pragma unroll
        for (int r = 0; r < 16; ++r) s[((r & 3) + 8 * (r >> 2)) * 128 + d * 32] = (unsigned short)(pk2(o[d][r], 0.f) & 0xffffu);
    const int row = lane >> 4, ch = lane & 15;
    bf16_t* g = op + (size_t)row * DM + ch * 8;
#pragma unroll 1
    for (int i = 0; i < 8; ++i) { const u32x4 v = *(const LAS u32x4*)(stg + (i * 4 + row) * 256 + ch * 16); *(u32x4*)g = v; g += 4 * DM; }
}

__device__ __forceinline__ void attn_phase(LAS unsigned char* lds, KP p, int l, int rep = 0) {
    unsigned char* ws = p->ws;
    const int tid0 = opq(threadIdx.x);
    unsigned* ctr = (unsigned*)(ws + WS_CTL) + 64 * l + 128 * rep;
    volatile LAS int* uidx = (volatile LAS int*)(lds + A_UIDX);
    LAS float* bt = (LAS float*)(lds + A_BIAS);
    const bf16_t* Hb = (const bf16_t*)(ws + WS_H); const bf16_t* Qb = (const bf16_t*)(ws + WS_Q); const bf16_t* KVb = (const bf16_t*)(ws + WS_KV);
    const bf16_t* KRb = (const bf16_t*)(ws + WS_KR); bf16_t* Ob = (bf16_t*)(ws + WS_O);
    const float* rope = (const float*)(ws + WS_ROPE);
    for (;;) {
        const int tid = opq(tid0), lane = tid & 63, r32 = lane & 31, hi = lane >> 5, wid = tid >> 6;
        if (tid == 0) uidx[0] = (int)atomicAdd(ctr, 1u);
        __syncthreads();
        int idx = uidx[0];
        __syncthreads();
        if (idx >= 1280) break;
#ifdef PROBE_ATTN2
        if (rep == 1 && idx < 256) continue;
#endif
        bool sample; int b, hh, qb, type;
        if (idx < 256) { sample = true; b = idx >> 4; const int h16 = idx & 15; qb = 0; if (h16 < 6) { type = 0; hh = h16; } else if (h16 < 10) { type = 1; hh = h16 - 6; } else { type = 2; hh = h16 - 10; } }
        else { sample = false; idx -= 256;
            if (idx < 400) { qb = 7 - idx / 80; const int r = idx % 80; b = r / 10; const int h10 = r % 10; if (h10 < 6) { type = 0; hh = h10; } else { type = 1; hh = h10 - 6; } }
            else if (idx < 784) { idx -= 400; qb = 7 - idx / 48; const int r = idx % 48; b = r / 6; hh = r % 6; type = 2; }
            else { idx -= 784; qb = 2 - idx / 80; const int r = idx % 80; b = r / 10; const int h10 = r % 10; if (h10 < 6) { type = 0; hh = h10; } else { type = 1; hh = h10 - 6; } } }
        const size_t qrow0 = sample ? (size_t)MP + b * 64 : (size_t)b * SEQ + qb * 256;
        const int qpos = (sample ? PAST : qb * 256) + wid * 32 + r32;
        const size_t myrow = qrow0 + wid * 32 + r32;
        AttnSrc a;
        a.Kf = nullptr; a.Kf2 = nullptr; a.Vf = nullptr; a.Vf2 = nullptr; a.ntc = 0;
        a.qmin = __builtin_amdgcn_readfirstlane((sample ? PAST : qb * 256) + wid * 32); a.kpos0 = 0;
        a.wave_on = sample ? (wid < 2) : true;
        const int cq = sample ? 0 : 4 * qb + (wid >> 1);
        f32x16 o[4];
        bf16_t* op = Ob + (qrow0 + wid * 32) * DM;
        if (type == 0) {
            const size_t kvrow0 = sample ? (size_t)MP + (size_t)b * SKV : (size_t)b * SEQ;
            a.K = KVb + kvrow0 * NKVC + hh * 256; a.kpitch = NKVC; a.K2 = KRb + kvrow0 * 64; a.k2pitch = 64; a.V = KVb + kvrow0 * NKVC + hh * 256 + 128; a.vpitch = NKVC;
            a.t0 = 0; a.t1 = sample ? 33 : 4 * qb + 4; a.lo_t = 0; a.hi_t = sample ? 32 : cq; a.scale2 = 0.07216878364870322f * LOG2E; a.bias_base = 0;
            bf16x8 qf[12];
            if (a.wave_on) {
                load_q<12>(qf, Qb + myrow * NQ + hh * 192 + hi * 8);
                const float* rp = rope + (size_t)qpos * 64;
#pragma unroll
                for (int d0 = 8; d0 < 10; ++d0) { bf16x8 x1 = qf[d0], x2 = qf[d0 + 2]; u32x4 y1, y2; const u32x4 u1 = __builtin_bit_cast(u32x4, x1), u2 = __builtin_bit_cast(u32x4, x2);
#pragma unroll
                    for (int e = 0; e < 4; ++e) { const int i = 16 * (d0 - 8) + 8 * hi + 2 * e; const float c0 = rp[i], s0 = rp[32 + i], c1 = rp[i + 1], s1 = rp[33 + i];
                        const float a0 = bflo(u1[e]), a1 = bfhi(u1[e]), b0 = bflo(u2[e]), b1 = bfhi(u2[e]);
                        y1[e] = pk2(a0 * c0 - b0 * s0, a1 * c1 - b1 * s1); y2[e] = pk2(a0 * s0 + b0 * c0, a1 * s1 + b1 * c1); }
                    qf[d0] = __builtin_bit_cast(bf16x8, y1); qf[d0 + 2] = __builtin_bit_cast(bf16x8, y2); }
            } else {
#pragma unroll
                for (int d0 = 0; d0 < 12; ++d0) qf[d0] = (bf16x8){0, 0, 0, 0, 0, 0, 0, 0};
            }
            attn_pass<192, 0>(lds, a, qf, o);
            if (a.wave_on) store_o(lds + wid * 8192, op + hh * 128, o, lane);
        } else if (type == 1) {
            const float* t5 = (const float*)(ws + WS_T5) + hh * T5N;
            for (int i = tid; i < T5N; i += 512) bt[i] = t5[i];
            const float lam = ((const float*)(ws + WS_LAM))[l]; const float lam_init = 0.8f - 0.6f * expf(-0.3f * (float)l);
            const bf16_t* kbase; const bf16_t* vbase; int pitch;
            if (sample) { kbase = nullptr; vbase = nullptr; pitch = 512; a.ntc = 32;
                a.Kf = p->in[I_CDK] + ((size_t)(l * NBS + b) * PAST) * 512 + hh * 128; a.Kf2 = p->out + O_SDK + ((size_t)(l * NBS + b) * DSEQ) * 512 + hh * 128;
                a.Vf = p->in[I_CDV] + ((size_t)(l * NBS + b) * PAST) * 512 + hh * 128; a.Vf2 = p->out + O_SDV + ((size_t)(l * NBS + b) * DSEQ) * 512 + hh * 128; }
            else { kbase = Hb + (size_t)b * SEQ * HWD + 512 + hh * 128; vbase = Hb + (size_t)b * SEQ * HWD + 1024 + hh * 128; pitch = HWD; }
            a.kpitch = pitch; a.K2 = nullptr; a.k2pitch = 0; a.V = vbase; a.vpitch = pitch;
            a.t0 = 0; a.t1 = sample ? 33 : 4 * qb + 4; a.lo_t = 0; a.hi_t = sample ? 32 : cq; a.scale2 = 0.125f * LOG2E; a.bias_base = 4 * hi - qpos + T5OFF;
            for (int c = 0; c < 2; ++c) {
                a.K = kbase + c * 64; const float* kf0 = a.Kf; const float* kf20 = a.Kf2; if (sample) { a.Kf = kf0 + c * 64; a.Kf2 = kf20 + c * 64; }
                bf16x8 qf[4];
                if (a.wave_on) load_q<4>(qf, Hb + myrow * HWD + hh * 128 + c * 64 + hi * 8);
                else {
#pragma unroll
                    for (int d0 = 0; d0 < 4; ++d0) qf[d0] = (bf16x8){0, 0, 0, 0, 0, 0, 0, 0};
                }
                if (sample) { attn_pass<64, 1, true>(lds, a, qf, o); a.Kf = kf0; a.Kf2 = kf20; } else attn_pass<64, 1>(lds, a, qf, o);
                if (c == 0 && a.wave_on) { LAS unsigned* st = (LAS unsigned*)(lds + A_STASH + wid * 8192) + lane;
#pragma unroll
                    for (int d = 0; d < 4; ++d)
#pragma unroll
                        for (int e = 0; e < 8; ++e) st[(d * 8 + e) * 64] = pk2(o[d][2 * e], o[d][2 * e + 1]); }
            }
            if (a.wave_on) {
                float ss[16];
#pragma unroll
                for (int r = 0; r < 16; ++r) ss[r] = 0.f;
#pragma unroll
                for (int d = 0; d < 4; ++d)
#pragma unroll
                    for (int e = 0; e < 8; ++e) { const unsigned sv = ((const LAS unsigned*)(lds + A_STASH + wid * 8192))[(d * 8 + e) * 64 + lane]; const float v0 = bflo(sv) - lam * o[d][2 * e], v1 = bfhi(sv) - lam * o[d][2 * e + 1]; o[d][2 * e] = v0; o[d][2 * e + 1] = v1; ss[2 * e] += v0 * v0; ss[2 * e + 1] += v1 * v1; }
#pragma unroll
                for (int r = 0; r < 16; ++r) {
#pragma unroll
                    for (int off = 1; off < 32; off <<= 1) ss[r] += __shfl_xor(ss[r], off);
                    ss[r] = rsqrtf(ss[r] * (1.f / 128.f) + 1e-6f) * (1.f - lam_init);
                }
                const float* sg = p->in[I_SUBLN] + l * 128;
#pragma unroll
                for (int d = 0; d < 4; ++d) { const float g = sg[d * 32 + r32];
#pragma unroll
                    for (int r = 0; r < 16; ++r) o[d][r] *= ss[r] * g; }
                store_o(lds + A_STASH + wid * 8192, op + 768 + hh * 128, o, lane);
            }
        } else {
            const float* br = p->in[I_BREL] + ((size_t)l * 6 + hh) * 513;
            for (int i = tid; i < 513; i += 512) bt[i] = br[i] * LOG2E;
            int kpos0;
            if (sample) { a.K = nullptr; a.V = nullptr; a.kpitch = 768; a.vpitch = 768; a.ntc = 8;
                a.Kf = p->in[I_CBK] + ((size_t)(l * NBS + b) * 512) * 768 + hh * 128; a.Kf2 = p->out + O_SBK + ((size_t)(l * NBS + b) * DSEQ) * 768 + hh * 128;
                a.Vf = p->in[I_CBV] + ((size_t)(l * NBS + b) * 512) * 768 + hh * 128; a.Vf2 = p->out + O_SBV + ((size_t)(l * NBS + b) * DSEQ) * 768 + hh * 128;
                a.t0 = 0; a.t1 = 9; a.lo_t = 0; a.hi_t = 8; kpos0 = PAST - 512; a.kpos0 = PAST - 512; }
            else { a.K = Hb + (size_t)b * SEQ * HWD + 2304 + hh * 128; a.V = Hb + (size_t)b * SEQ * HWD + 3072 + hh * 128; a.kpitch = HWD; a.vpitch = HWD;
                a.t0 = max(0, 4 * qb - 8); a.t1 = 4 * qb + 4; a.lo_t = cq - 8; a.hi_t = cq; kpos0 = 0; }
            a.K2 = nullptr; a.k2pitch = 0; a.scale2 = 0.08838834764831845f * LOG2E; a.bias_base = qpos - kpos0 - 4 * hi;
            bf16x8 qf[8];
            if (a.wave_on) load_q<8>(qf, Hb + myrow * HWD + 1536 + hh * 128 + hi * 8);
            else {
#pragma unroll
                for (int d0 = 0; d0 < 8; ++d0) qf[d0] = (bf16x8){0, 0, 0, 0, 0, 0, 0, 0};
            }
            if (sample) attn_pass<128, 2, true>(lds, a, qf, o); else attn_pass<128, 2>(lds, a, qf, o);
            if (a.wave_on) store_o(lds + wid * 8192, op + 1280 + hh * 128, o, lane);
        }
        __syncthreads();
    }
}


#define XB_TMO      128
#define XB_XCNT(j)  (256  + 64 * (j))
#define XB_XSUB(j)  (1280 + 64 * (j))
#define XB_XGEN(j)  (2304 + 64 * (j))
#define XB_TOP      3328
#define XB_TOPGEN   3392
#define XCD_BAR_WORDS 3456
#define XB_SPIN_CAP (1u << 22)
__device__ __forceinline__ unsigned xb_ld(unsigned* p)              { return __hip_atomic_load(p, __ATOMIC_RELAXED, __HIP_MEMORY_SCOPE_AGENT); }
__device__ __forceinline__ unsigned xb_add(unsigned* p, unsigned v) { return __hip_atomic_fetch_add(p, v, __ATOMIC_RELAXED, __HIP_MEMORY_SCOPE_AGENT); }
__device__ __forceinline__ unsigned xb_xcc_id() { return (unsigned)__builtin_amdgcn_s_getreg((3 << 11) | 20) & 0xFu; }
#define XB_SPIN(cond, bar) do { unsigned _sp = 0; while (cond) { __builtin_amdgcn_s_sleep(1); \
    if ((++_sp & 255u) == 0u) { if (xb_ld(&(bar)[XB_TMO])) break; if (_sp > XB_SPIN_CAP) { atomicAdd(&(bar)[XB_TMO], 1u); break; } } } } while (0)
struct XcdBarrier { unsigned* bar; unsigned x; volatile LAS unsigned* st; };
__device__ __forceinline__ XcdBarrier xcd_barrier_post(unsigned* bar, volatile LAS unsigned* st) {
    XcdBarrier b; b.bar = bar; b.x = xb_xcc_id(); b.st = st;
    if (threadIdx.x == 0) (void)xb_add(&bar[XB_XCNT(b.x)], 1u);
    return b;
}
__device__ __forceinline__ void xcd_barrier_complete(unsigned* bar, unsigned x, unsigned& nloc, unsigned& nx) {
    const unsigned G = gridDim.x * gridDim.y * gridDim.z;
    unsigned sum, cnt, mine, sp = 0u;
    for (;;) {
        sum = 0u; cnt = 0u; mine = 0u;
#pragma unroll
        for (unsigned j = 0; j < 16; ++j) { const unsigned c = xb_ld(&bar[XB_XCNT(j)]); sum += c; cnt += (c > 0u) ? 1u : 0u; mine = (j == x) ? c : mine; }
        if (sum == G) break;
        __builtin_amdgcn_s_sleep(1);
        if ((++sp & 255u) == 0u) { if (xb_ld(&bar[XB_TMO])) break; if (sp > XB_SPIN_CAP) { atomicAdd(&bar[XB_TMO], 1u); break; } }
    }
    nloc = mine > 0u ? mine : 1u; nx = cnt > 0u ? cnt : 1u;
}
__device__ __forceinline__ void xcd_barrier(const XcdBarrier& b) {
    asm volatile("s_waitcnt vmcnt(0)" ::: "memory");
    __syncthreads();
    if (threadIdx.x == 0) {
        unsigned* bar = b.bar;
        __builtin_amdgcn_s_waitcnt(0);
        unsigned nloc = b.st[0], nx = b.st[1];
        if (nloc == 0u) { xcd_barrier_complete(bar, b.x, nloc, nx); b.st[0] = nloc; b.st[1] = nx; }
        const unsigned old = xb_add(&bar[XB_XSUB(b.x)], 1u);
        const unsigned gen = old / nloc;
        if (old + 1u == (gen + 1u) * nloc) {
            __builtin_amdgcn_fence(__ATOMIC_RELEASE, "agent");
            asm volatile("s_waitcnt vmcnt(0)" ::: "memory");
            const unsigned og = xb_add(&bar[XB_TOP], 1u);
            const unsigned tg = og / nx;
            if (og + 1u == (tg + 1u) * nx) xb_add(&bar[XB_TOPGEN], 1u);
            else XB_SPIN(xb_ld(&bar[XB_TOPGEN]) == tg, bar);
            __builtin_amdgcn_fence(__ATOMIC_ACQUIRE, "agent");
            xb_add(&bar[XB_XGEN(b.x)], 1u);
            asm volatile("s_waitcnt vmcnt(0)" ::: "memory");
        } else {
            XB_SPIN(xb_ld(&bar[XB_XGEN(b.x)]) == gen, bar);
            __builtin_amdgcn_fence(__ATOMIC_ACQUIRE, "agent");
            asm volatile("s_waitcnt vmcnt(0)" ::: "memory");
        }
    }
    __syncthreads();
}

__device__ __forceinline__ unsigned char* lws(unsigned char* q) { asm volatile("" : "+s"(q)); return q; }
__global__ void __launch_bounds__(512, 2) fwd_kernel(Params p) {
    extern __shared__ __attribute__((aligned(16))) unsigned char lds_raw[];
    LAS unsigned char* lds0 = (LAS unsigned char*)lds_raw;
    LAS unsigned char* lds = lds0; asm volatile("" : "+s"(lds));
    cg::grid_group grid = cg::this_grid();
    volatile LAS unsigned* bst = (volatile LAS unsigned*)(lds + 131072 + 320);
    if (threadIdx.x < 2) bst[threadIdx.x] = 0u;
    __syncthreads();
    const XcdBarrier xbar = xcd_barrier_post((unsigned*)(kparams()->ws + WS_BAR), bst);
#ifndef NO_PRO
    prologue(lds, kparams());
#endif
#ifdef PROBE_PRO2
    __syncthreads(); prologue(lds, kparams());
#endif
    grid.sync();
#pragma unroll 1
    for (int ph = 0; ph < 20; ++ph) {
        const int l = opqs(ph / 10), s = opqs(ph % 10);
        KP kp = kparams();
        LAS unsigned char* lds = lds0; asm volatile("" : "+s"(lds));
        unsigned char* ws = lws(kp->ws);
        const int G = opss(gridDim.x), bx = opss(blockIdx.x);
        if (s == 0) {
#ifndef NO_G1
            pg8::Gemm g{(const bf16_t*)(ws + WS_XB), (const bf16_t*)(ws + WS_WIN), MT, NIN, DM}; pg8::StaticOrder S; S.init(MT, NIN, DM, G, bx);
            EpiIn E{(float*)(ws + WS_RAW), (bf16_t*)(ws + WS_H), kp->out, l};
            pg8::gemm_phase<EpiIn, pg8::StaticOrder, true, true>(lds, g, S, E);
            cvt_queue(lds, kparams(), l);
#ifdef PROBE_GEMMS2
            __syncthreads(); pg8::gemm_phase<EpiIn, pg8::StaticOrder, true, true>(lds, g, S, E);
#endif
#endif
        } else if (s == 1) {
#ifndef NO_POST
            post_in_phase(kp, l);
#ifdef PROBE_POST2
            post_in_phase(kparams(), l);
#endif
#endif
        } else if (s == 2) {
#ifndef NO_G2
            { pg8::Gemm g{(const bf16_t*)(ws + WS_CQN), (const bf16_t*)(ws + WS_WUQ), MT, NQ, 512}; pg8::StaticOrder S; S.init(MT, NQ, 512, G, bx);
              EpiBf E{(bf16_t*)(ws + WS_Q), NQ};
              pg8::gemm_phase<EpiBf, pg8::StaticOrder, true, true>(lds, g, S, E);
#ifdef PROBE_GEMMS2
              __syncthreads(); pg8::gemm_phase<EpiBf, pg8::StaticOrder, true, true>(lds, g, S, E);
#endif
              }
            { unsigned char* ws2 = lws(kp->ws); const int G2 = opss(gridDim.x), bx2 = opss(blockIdx.x);
              pg8::Gemm g2{(const bf16_t*)(ws2 + WS_CKVA), (const bf16_t*)(ws2 + WS_WUKV), MKV, NKVC, 256}; pg8::StaticOrder S2; S2.init(MKV, NKVC, 256, G2, bx2);
              EpiBf E2{(bf16_t*)(ws2 + WS_KV), NKVC};
              pg8::gemm_phase<EpiBf, pg8::StaticOrder, true, true>(lds, g2, S2, E2);
#ifdef PROBE_GEMMS2
              __syncthreads(); pg8::gemm_phase<EpiBf, pg8::StaticOrder, true, true>(lds, g2, S2, E2);
#endif
              }
#endif
        } else if (s == 3) {
#ifndef NO_ATTN
            attn_phase(lds, kp, l);
#ifdef PROBE_ATTN2
            __syncthreads(); attn_phase(lds, kparams(), l, 1);
#endif
#endif
        } else if (s == 4) {
#ifndef NO_G3
            pg8::Gemm g{(const bf16_t*)(ws + WS_O), (const bf16_t*)(ws + WS_WO), MT, DM, DM}; pg8::TailOrder S; S.init(DM, G, bx);
            EpiRes E{(float*)(ws + WS_Z), (float*)(ws + WS_SLAB), l == 0 ? kp->in[I_XP] : nullptr, l == 0 ? kp->in[I_XS] : nullptr, (const float*)(ws + WS_STATS),
                     kp->in[I_LN2G] + (l - 1) * DM, kp->in[I_LN2B] + (l - 1) * DM, DM};
            pg8::gemm_phase<EpiRes, pg8::TailOrder, true, true>(lds, g, S, E);
#ifdef PROBE_GEMMS2
            __syncthreads(); pg8::gemm_phase<EpiRes, pg8::TailOrder, true, true>(lds, g, S, E);
#endif
#endif
        } else if (s == 5) {
            ln_phase((float*)(ws + WS_Z), (const float*)(ws + WS_SLAB), kp->in[I_LN1G] + l * DM, kp->in[I_LN1B] + l * DM, (float*)(ws + WS_STATS), nullptr, (bf16_t*)(ws + WS_XB));
#ifdef PROBE_LN2
            ln_phase((float*)(ws + WS_Z), (const float*)(ws + WS_SLAB), kp->in[I_LN1G] + l * DM, kp->in[I_LN1B] + l * DM, (float*)(ws + WS_STATS), nullptr, (bf16_t*)(ws + WS_XB));
#endif
        } else if (s == 6) {
#ifndef NO_G4
            pg8::Gemm g{(const bf16_t*)(ws + WS_XB), (const bf16_t*)(ws + WS_WGU), MT, 2 * DFF, DM}; pg8::StaticOrder S; S.init(MT, 2 * DFF, DM, G, bx);
            EpiGU E{(bf16_t*)(ws + WS_U), (bf16_t*)(ws + WS_GH), (bf16_t*)(ws + WS_UH), kp->in[I_CW] + (size_t)l * 3 * DFF, kp->in[I_CB] + (size_t)l * DFF};
            pg8::gemm_phase<EpiGU, pg8::StaticOrder, true, true>(lds, g, S, E);
#ifdef PROBE_G42
            __syncthreads(); pg8::gemm_phase<EpiGU, pg8::StaticOrder, true, true>(lds, g, S, E);
#endif
#endif
        } else if (s == 7) {
#ifndef NO_CONV
            fixup_phase(kp, l);
#endif
        } else if (s == 8) {
#ifndef NO_G5
            pg8::Gemm g{(const bf16_t*)(ws + WS_U), (const bf16_t*)(ws + WS_WD), MT, DM, DFF}; pg8::TailOrder S; S.init(DFF, G, bx);
            EpiRes E{(float*)(ws + WS_Z), (float*)(ws + WS_SLAB), nullptr, nullptr, (const float*)(ws + WS_STATS), kp->in[I_LN1G] + l * DM, kp->in[I_LN1B] + l * DM, DFF};
            pg8::gemm_phase<EpiRes, pg8::TailOrder, true, true>(lds, g, S, E);
#ifdef PROBE_GEMMS2
            __syncthreads(); pg8::gemm_phase<EpiRes, pg8::TailOrder, true, true>(lds, g, S, E);
#endif
#endif
        } else {
            ln_phase((float*)(ws + WS_Z), (const float*)(ws + WS_SLAB), kp->in[I_LN2G] + l * DM, kp->in[I_LN2B] + l * DM, (float*)(ws + WS_STATS), l == 1 ? kp->out : nullptr, (bf16_t*)(ws + WS_XB));
#ifdef PROBE_LN2
            ln_phase((float*)(ws + WS_Z), (const float*)(ws + WS_SLAB), kp->in[I_LN2G] + l * DM, kp->in[I_LN2B] + l * DM, (float*)(ws + WS_STATS), l == 1 ? kp->out : nullptr, (bf16_t*)(ws + WS_XB));
#endif
            if (l == 0) { __syncthreads(); convert_weights(lds, kp, 1); }
        }
        if (ph == 19) break;
#ifdef USE_CG_SYNC
        grid.sync();
#else
        xcd_barrier(xbar);
#endif
#ifdef PROBE_BAR
        xcd_barrier(xbar);
#endif
    }
}

extern "C" void kernel_launch(void* const* d_in, const int* in_sizes, int n_in, void* d_out, int out_size, void* d_ws, size_t ws_size, hipStream_t stream) {
    static int grid_blocks = 0;
    if (grid_blocks == 0) {
        if (n_in != 31 || (size_t)out_size != O_END || ws_size < WS_END) { fprintf(stderr, "kernel_launch: unexpected shapes n_in %d out %d (want %zu) ws %zu (need %zu)\n", n_in, out_size, (size_t)O_END, ws_size, (size_t)WS_END); grid_blocks = -1; return; }
        int dev = 0, cus = 0, per_cu = 0;
        (void)hipGetDevice(&dev); (void)hipDeviceGetAttribute(&cus, hipDeviceAttributeMultiprocessorCount, dev);
        if (hipFuncSetAttribute((const void*)fwd_kernel, hipFuncAttributeMaxDynamicSharedMemorySize, LDS_BYTES) != hipSuccess) { fprintf(stderr, "kernel_launch: hipFuncSetAttribute failed\n"); grid_blocks = -1; return; }
        if (hipOccupancyMaxActiveBlocksPerMultiprocessor(&per_cu, (const void*)fwd_kernel, 512, LDS_BYTES) != hipSuccess || per_cu < 1) per_cu = 1;
        (void)hipGetLastError();
        grid_blocks = cus * (per_cu > 1 ? 1 : per_cu);
    }
    if (grid_blocks < 0) return;
    (void)hipMemsetAsync((char*)d_ws + WS_CTL, 0, CTL_BYTES, stream);
    Params p{};
    for (int i = 0; i < 31; ++i) p.in[i] = (const float*)d_in[i];
    p.out = (float*)d_out; p.ws = (unsigned char*)d_ws;
    void* args[] = {&p};
    hipError_t e = hipLaunchCooperativeKernel((const void*)fwd_kernel, dim3(grid_blocks), dim3(512), args, LDS_BYTES, stream);
    if (e != hipSuccess) fprintf(stderr, "cooperative launch failed: %s (grid %d)\n", hipGetErrorString(e), grid_blocks);
}
```

```cpp
#include <hip/hip_runtime.h>
#include <hip/hip_cooperative_groups.h>
#include <cstdio>
#include <cstdint>
namespace cg = cooperative_groups;

#define LAS __attribute__((address_space(3)))
typedef unsigned short bf16_t;
typedef short bf16x8 __attribute__((ext_vector_type(8)));
typedef float f32x4 __attribute__((ext_vector_type(4)));
typedef float f32x16 __attribute__((ext_vector_type(16)));
typedef unsigned u32x4 __attribute__((ext_vector_type(4)));
typedef unsigned u32x2 __attribute__((ext_vector_type(2)));

constexpr int DM = 2048, NBP = 8, SEQ = 2048, NBS = 16, DSEQ = 64, PAST = 2048;
constexpr int MP = NBP * SEQ, MS = NBS * DSEQ, MT = MP + MS;
constexpr int SKV = PAST + DSEQ;
constexpr int MKV = MP + NBS * SKV;
constexpr int NIN = 4864, RAWW = 1024, HWD = 3840, DFF = 5632, NQ = 1280, NKVC = 1536;
constexpr int BKS = 576;
constexpr float LOG2E = 1.4426950408889634f;
constexpr float ALPHA = 1.4142135623730951f;

constexpr size_t O_Y = 0;
constexpr size_t O_PCKV = (size_t)MT * DM;
constexpr size_t O_PKR = O_PCKV + 2ull * 8 * 2048 * 256;
constexpr size_t O_PDK = O_PKR + 2ull * 8 * 2048 * 64;
constexpr size_t O_PDV = O_PDK + 2ull * 8 * 2048 * 512;
constexpr size_t O_PBK = O_PDV + 2ull * 8 * 2048 * 512;
constexpr size_t O_PBV = O_PBK + 2ull * 8 * 512 * 768;
constexpr size_t O_PCONV = O_PBV + 2ull * 8 * 512 * 768;
constexpr size_t O_SCKV = O_PCONV + 2ull * 8 * 2 * DFF;
constexpr size_t O_SKR = O_SCKV + 2ull * 16 * 64 * 256;
constexpr size_t O_SDK = O_SKR + 2ull * 16 * 64 * 64;
constexpr size_t O_SDV = O_SDK + 2ull * 16 * 64 * 512;
constexpr size_t O_SBK = O_SDV + 2ull * 16 * 64 * 512;
constexpr size_t O_SBV = O_SBK + 2ull * 16 * 64 * 768;
constexpr size_t O_SCONV = O_SBV + 2ull * 16 * 64 * 768;
constexpr size_t O_END = O_SCONV + 2ull * 16 * 2 * DFF;

constexpr size_t al256(size_t x) { return (x + 255) & ~(size_t)255; }
constexpr size_t WS_CTL = 0;
constexpr size_t WS_BAR = 16384;
constexpr size_t CTL_BYTES = 65536;
constexpr size_t WS_LAM = 65536;
constexpr size_t WS_ROPE = 65536 + 4096;
constexpr size_t WS_T5 = al256(WS_ROPE + (size_t)SKV * 64 * 4);
constexpr int T5N = 2176, T5OFF = 2111;
constexpr size_t WS_STATS = al256(WS_T5 + 4ull * T5N * 4);
constexpr size_t WS_WIN = al256(WS_STATS + (size_t)MT * 8);
constexpr size_t WS_WUQ = WS_WIN + (size_t)NIN * DM * 2;
constexpr size_t WS_WUKV = WS_WUQ + (size_t)NQ * 512 * 2;
constexpr size_t WS_WO = WS_WUKV + (size_t)NKVC * 256 * 2;
constexpr size_t WS_WGU = WS_WO + (size_t)DM * DM * 2;
constexpr size_t WS_WD = WS_WGU + 2ull * DFF * DM * 2;
constexpr size_t WS_XB = WS_WD + (size_t)DM * DFF * 2;
constexpr size_t WS_XF = WS_XB + (size_t)MT * DM * 2;
constexpr size_t WS_C0 = WS_XF + (size_t)MT * DM * 4;
constexpr size_t WS_RAW = WS_C0;
constexpr size_t WS_H = WS_RAW + (size_t)MT * RAWW * 4;
constexpr size_t WS_Z = WS_XF;
constexpr size_t WS_SLAB = WS_C0 + (32u << 20);
constexpr size_t WS_GH = WS_C0;
constexpr size_t WS_UH = WS_C0 + (16u << 20);
constexpr size_t WS_C1 = WS_H + (size_t)MT * HWD * 2;
constexpr size_t WS_Q = WS_C1;
constexpr size_t WS_KV = WS_Q + (size_t)MT * NQ * 2;
constexpr size_t WS_U = WS_C1;
constexpr size_t WS_C2 = WS_KV + (size_t)MKV * NKVC * 2;
constexpr size_t WS_O = WS_C2;
constexpr size_t WS_CKVA = WS_O + (size_t)MT * DM * 2;
constexpr size_t WS_KR = WS_CKVA + (size_t)MKV * 256 * 2;
constexpr size_t WS_CQN = WS_KR + (size_t)MKV * 64 * 2;
constexpr size_t WS_DKS = WS_CQN + (size_t)MT * 512 * 2;
constexpr size_t WS_DVS = WS_DKS + (size_t)NBS * SKV * 512 * 2;
constexpr size_t WS_BKS = WS_DVS + (size_t)NBS * SKV * 512 * 2;
constexpr size_t WS_BVS = WS_BKS + (size_t)NBS * BKS * 768 * 2;
constexpr size_t WS_END = WS_BVS + (size_t)NBS * BKS * 768 * 2;
static_assert((size_t)MT * DFF * 2 <= WS_C2 - WS_C1, "U fits C1");
static_assert((32u << 20) + 7ull * MS * DM * 4 <= WS_C1 - WS_C0, "split-K slabs fit C0");

constexpr int LDS_BYTES = 147456;

__device__ __forceinline__ unsigned pk2(float lo, float hi) {
    typedef float f2 __attribute__((ext_vector_type(2))); typedef __bf16 b2 __attribute__((ext_vector_type(2)));
    f2 v = {lo, hi}; b2 b = __builtin_convertvector(v, b2); return __builtin_bit_cast(unsigned, b);
}
__device__ __forceinline__ float bflo(unsigned u) { return __uint_as_float(u << 16); }
__device__ __forceinline__ float bfhi(unsigned u) { return __uint_as_float(u & 0xffff0000u); }
__device__ __forceinline__ float wave_sum(float v) {
#pragma unroll
    for (int o = 1; o < 64; o <<= 1) v += __shfl_xor(v, o);
    return v;
}
__device__ __forceinline__ int opq(int v) { asm volatile("" : "+v"(v)); return v; }
__device__ __forceinline__ int opqs(int v) { v = __builtin_amdgcn_readfirstlane(v); asm volatile("" : "+s"(v)); return v; }
__device__ __forceinline__ int opss(int v) { asm volatile("" : "+s"(v)); return v; }
__device__ __forceinline__ int crow(int r, int hi) { return (r & 3) + 8 * (r >> 2) + 4 * hi; }

namespace pg8 {
constexpr int BM = 256, BK = 64, HALF = 128, HTB = HALF * BK * 2, STAGE_BYTES = 8 * HTB, NXCD = 8, WGM = 8;
__host__ __device__ __forceinline__ int lds_byte(int r, int c) { const int st = (r >> 4) * 2 + (c >> 5), rr = r & 15, cc = c & 31, ob = rr * 64 + cc * 2; return st * 1024 + (ob ^ (((ob >> 9) & 1) << 5)); }
__host__ __device__ __forceinline__ void stage_rc(int b, int& R, int& C) { const int st = b / 1024, sb = b % 1024, swz = sb ^ (((sb >> 9) & 1) << 5); R = (st >> 1) * 16 + swz / 64; C = (st & 1) * 32 + (swz % 64) / 2; }
__host__ __device__ __forceinline__ int perm32(int rho) { const int n = rho >> 4, i = rho & 15; return 8 * (i >> 2) + 4 * n + (i & 3); }

struct Unit { int pm, pn, koff, nt; };
struct Gemm { const bf16_t* A; const bf16_t* Bt; int M, N, K; };

struct StaticOrder {
    int nM, nN, nwg, G, c, nt0;
    __device__ void init(int M, int N, int K, int G_, int c_) { nM = M / BM; nN = N / BM; nwg = nM * nN; G = G_; c = c_; nt0 = K / BK; }
    __device__ bool next(int i, Unit& u) const { const long L = (long)i * G + c; if (L >= nwg) return false; at((int)L, u); return true; }
    __device__ void at(int wgid, Unit& u) const {
        { const int q = nwg / NXCD, r = nwg % NXCD, xcd = wgid % NXCD, off = wgid / NXCD; wgid = (xcd < r ? xcd * (q + 1) : r * (q + 1) + (xcd - r) * q) + off; }
        const int nig = WGM * nN, gid = wgid / nig, fm = gid * WGM, gsz = (nM - fm) < WGM ? (nM - fm) : WGM;
        u.pm = fm + ((wgid % nig) % gsz); u.pn = (wgid % nig) / gsz; u.koff = 0; u.nt = nt0;
    }
    __device__ __forceinline__ void a_ready(const Unit&) const {}
    __device__ __forceinline__ void done(const Unit&) const {}
};


struct TailOrder {
    StaticOrder so; int K;
    __device__ void init(int K_, int G_, int c_) { so.init(MP, DM, K_, G_, c_); K = K_; }
    __device__ bool next(int i, Unit& u) const {
        const long L = (long)i * so.G + so.c;
        if (L < so.nwg) { so.at((int)L, u); return true; }
        const long j = L - so.nwg; if (j >= 256) return false;
        const int ks = (int)(j & 7), tile = (int)(j >> 3); u.pm = 64 + (tile >> 3); u.pn = tile & 7;
        if (K == DM) { u.koff = ks * 256; u.nt = 4; }
        else { u.koff = 64 * (22 * (ks >> 1) + ((ks & 1) ? 12 : 0)); u.nt = (ks & 1) ? 10 : 12; }
        return true;
    }
    __device__ __forceinline__ void a_ready(const Unit&) const {}
    __device__ __forceinline__ void done(const Unit&) const {}
};

template <class Epi, class Sched, bool ALIGN_EPI = false, bool SP2 = false>
__device__ __forceinline__ void gemm_phase(LAS unsigned char* lds, const Gemm g, const Sched& S, const Epi& E) {
    const int tid = opq(threadIdx.x), wid = __builtin_amdgcn_readfirstlane(tid >> 6), lane = tid & 63, wr = wid >> 2, wc = wid & 3, fr = lane & 15, fq = lane >> 4;
    const int K = g.K;
    unsigned voffA[2], voffB[2];
#pragma unroll
    for (int i = 0; i < 2; ++i) { int R, C; stage_rc(tid * 16 + i * 8192, R, C); const int Rb = Epi::PERM ? ((R & ~31) + perm32(R & 31)) : R;
        voffA[i] = (unsigned)(R * K + C) * 2u; voffB[i] = (unsigned)(Rb * K + C) * 2u; }
    const size_t kstep = (size_t)(BK * 2);
    const size_t hstep = (size_t)HALF * K * 2;
    const size_t tstep = 2 * hstep;
    const unsigned ldsw = (unsigned)wid * 1024u;
    const int aoff = lds_byte(wr * 64 + fr, fq * 8), boff = lds_byte(wc * 32 + fr, fq * 8);
#define PG8_SA(b, h) (((b) * 2 + (h)) * HTB)
#define PG8_SB(b, h) ((4 + (b) * 2 + (h)) * HTB)
#define PG8_STAGE(bufoff, gbase, voff) do { _Pragma("unroll") for (int _i = 0; _i < 2; ++_i) \
        __builtin_amdgcn_global_load_lds((const unsigned*)((const char*)(gbase) + (voff)[_i]), (LAS unsigned*)(lds + (bufoff) + ldsw + _i * 8192), 16, 0, 0); } while (0)
#define PG8_LDA(dst, b, h) do { _Pragma("unroll") for (int m = 0; m < 4; ++m) _Pragma("unroll") for (int k = 0; k < 2; ++k) dst[m][k] = *(const LAS bf16x8*)(lds + PG8_SA(b, h) + aoff + m * 2048 + k * 1024); } while (0)
#define PG8_LDB(dst, b, h) do { _Pragma("unroll") for (int n = 0; n < 2; ++n) _Pragma("unroll") for (int k = 0; k < 2; ++k) dst[n][k] = *(const LAS bf16x8*)(lds + PG8_SB(b, h) + boff + n * 2048 + k * 1024); } while (0)
#define PG8_MMA(ai, bj, At, Bt) do { __builtin_amdgcn_s_setprio(1); _Pragma("unroll") for (int m = 0; m < 4; ++m) _Pragma("unroll") for (int n = 0; n < 2; ++n) _Pragma("unroll") for (int k = 0; k < 2; ++k) \
        acc[ai][bj][m][n] = __builtin_amdgcn_mfma_f32_16x16x32_bf16(Bt[n][k], At[m][k], acc[ai][bj][m][n], 0, 0, 0); __builtin_amdgcn_s_setprio(0); } while (0)
#define PG8_WAIT_V(n) asm volatile("s_waitcnt vmcnt(" #n ")" ::: "memory")
#define PG8_WAIT_L(n) asm volatile("s_waitcnt lgkmcnt(" #n ")" ::: "memory")
#define PG8_BAR __builtin_amdgcn_s_barrier()
#define PG8_SCHED __builtin_amdgcn_sched_barrier(0)
    Unit cur, nxt; int ui = 0;
    if (!S.next(0, cur)) return;
    f32x4 acc[2][2][4][2];
#pragma unroll
    for (int a = 0; a < 2; ++a)
#pragma unroll
        for (int b = 0; b < 2; ++b)
#pragma unroll
            for (int m = 0; m < 4; ++m)
#pragma unroll
                for (int n = 0; n < 2; ++n) acc[a][b][m][n] = (f32x4){0.f, 0.f, 0.f, 0.f};
    bf16x8 At[4][2], B0[2][2], B1[2][2];
    const char* cA = (const char*)g.A + (size_t)cur.pm * tstep + (size_t)cur.koff * 2; const char* cB = (const char*)g.Bt + (size_t)cur.pn * tstep + (size_t)cur.koff * 2;
    S.a_ready(cur);
    if constexpr (SP2) {
        PG8_STAGE(PG8_SB(0, 0), cB, voffB); PG8_STAGE(PG8_SB(0, 1), cB + hstep, voffB); PG8_STAGE(PG8_SA(0, 0), cA, voffA); PG8_STAGE(PG8_SA(0, 1), cA + hstep, voffA);
        if (wr == 1) PG8_BAR;
        PG8_WAIT_V(2); PG8_BAR;
        PG8_STAGE(PG8_SB(1, 0), cB + kstep, voffB); PG8_STAGE(PG8_SA(1, 0), cA + kstep, voffA); PG8_STAGE(PG8_SB(1, 1), cB + hstep + kstep, voffB);
        PG8_WAIT_V(6); PG8_BAR;
    } else {
        PG8_STAGE(PG8_SB(0, 0), cB, voffB); PG8_STAGE(PG8_SA(0, 0), cA, voffA); PG8_STAGE(PG8_SB(0, 1), cB + hstep, voffB); PG8_STAGE(PG8_SA(0, 1), cA + hstep, voffA);
        if (wr == 1) PG8_BAR;
        PG8_WAIT_V(4); PG8_BAR;
        PG8_STAGE(PG8_SB(1, 0), cB + kstep, voffB); PG8_STAGE(PG8_SA(1, 0), cA + kstep, voffA); PG8_STAGE(PG8_SB(1, 1), cB + hstep + kstep, voffB);
        PG8_WAIT_V(6); PG8_BAR;
    }
    for (;;) {
        const bool has_next = S.next(ui + 1, nxt);
        const char* nA = has_next ? (const char*)g.A + (size_t)nxt.pm * tstep + (size_t)nxt.koff * 2 : cA; const char* nB = has_next ? (const char*)g.Bt + (size_t)nxt.pn * tstep + (size_t)nxt.koff * 2 : cB;
        const int nt = cur.nt;
        for (int t = 0; t < nt; t += 2) {
            const bool last = (t == nt - 2);
            const char* a1 = cA + (size_t)(t + 1) * kstep;
            const char* a2 = last ? nA : cA + (size_t)(t + 2) * kstep; const char* b2 = last ? nB : cB + (size_t)(t + 2) * kstep;
            const char* a3 = a2 + kstep; const char* b3 = b2 + kstep;
            if (last && has_next) S.a_ready(nxt);
            if constexpr (SP2) {
            PG8_LDB(B0, 0, 0); PG8_LDB(B1, 0, 1); PG8_SCHED; PG8_LDA(At, 0, 0); PG8_STAGE(PG8_SA(1, 1), a1 + hstep, voffA);
            PG8_WAIT_V(8); PG8_WAIT_L(0); PG8_BAR; PG8_MMA(0, 0, At, B0); PG8_MMA(0, 1, At, B1); PG8_BAR; PG8_SCHED;
            PG8_LDA(At, 0, 1); PG8_STAGE(PG8_SB(0, 0), b2, voffB); PG8_STAGE(PG8_SB(0, 1), b2 + hstep, voffB); PG8_STAGE(PG8_SA(0, 0), a2, voffA);
            PG8_WAIT_V(8); PG8_WAIT_L(0); PG8_BAR; PG8_MMA(1, 0, At, B0); PG8_MMA(1, 1, At, B1); PG8_BAR; PG8_SCHED;
            PG8_LDB(B0, 1, 0); PG8_LDB(B1, 1, 1); PG8_SCHED; PG8_LDA(At, 1, 0); PG8_STAGE(PG8_SA(0, 1), a2 + hstep, voffA);
            PG8_WAIT_V(8); PG8_WAIT_L(0); PG8_BAR; PG8_MMA(0, 0, At, B0); PG8_MMA(0, 1, At, B1); PG8_BAR; PG8_SCHED;
            PG8_LDA(At, 1, 1); PG8_STAGE(PG8_SB(1, 0), b3, voffB); PG8_STAGE(PG8_SB(1, 1), b3 + hstep, voffB); PG8_STAGE(PG8_SA(1, 0), a3, voffA);
            PG8_WAIT_V(8); PG8_WAIT_L(0); PG8_BAR; PG8_MMA(1, 0, At, B0); PG8_MMA(1, 1, At, B1); PG8_BAR; PG8_SCHED;
            } else {
            PG8_LDB(B0, 0, 0); PG8_SCHED; PG8_LDA(At, 0, 0); PG8_STAGE(PG8_SA(1, 1), a1 + hstep, voffA);
            PG8_WAIT_L(8); PG8_BAR; PG8_WAIT_L(0); PG8_MMA(0, 0, At, B0); PG8_BAR; PG8_SCHED;
            PG8_LDB(B1, 0, 1); PG8_STAGE(PG8_SB(0, 0), b2, voffB);
            PG8_BAR; PG8_WAIT_L(0); PG8_MMA(0, 1, At, B1); PG8_BAR;
            PG8_LDA(At, 0, 1); PG8_STAGE(PG8_SA(0, 0), a2, voffA);
            PG8_BAR; PG8_WAIT_L(0); PG8_MMA(1, 0, At, B0); PG8_BAR; PG8_SCHED;
            PG8_STAGE(PG8_SB(0, 1), b2 + hstep, voffB);
            PG8_WAIT_V(6); PG8_BAR; PG8_MMA(1, 1, At, B1); PG8_BAR;
            PG8_LDB(B0, 1, 0); PG8_SCHED; PG8_LDA(At, 1, 0); PG8_STAGE(PG8_SA(0, 1), a2 + hstep, voffA);
            PG8_WAIT_L(8); PG8_BAR; PG8_WAIT_L(0); PG8_MMA(0, 0, At, B0); PG8_BAR; PG8_SCHED;
            PG8_LDB(B1, 1, 1); PG8_STAGE(PG8_SB(1, 0), b3, voffB);
            PG8_BAR; PG8_WAIT_L(0); PG8_MMA(0, 1, At, B1); PG8_BAR;
            PG8_LDA(At, 1, 1); PG8_STAGE(PG8_SA(1, 0), a3, voffA);
            PG8_BAR; PG8_WAIT_L(0); PG8_MMA(1, 0, At, B0); PG8_BAR; PG8_SCHED;
            PG8_STAGE(PG8_SB(1, 1), b3 + hstep, voffB);
            PG8_WAIT_V(6); PG8_BAR; PG8_MMA(1, 1, At, B1); PG8_BAR;
            }
        }
        if constexpr (ALIGN_EPI) { if (wr == 0) PG8_BAR; }
        E(acc, cur, wr, wc, fr, fq); S.done(cur);
        if (!has_next) break;
#pragma unroll
        for (int a = 0; a < 2; ++a)
#pragma unroll
            for (int b = 0; b < 2; ++b)
#pragma unroll
                for (int m = 0; m < 4; ++m)
#pragma unroll
                    for (int n = 0; n < 2; ++n) acc[a][b][m][n] = (f32x4){0.f, 0.f, 0.f, 0.f};
        cur = nxt; cA = nA; cB = nB; ++ui;
        if constexpr (ALIGN_EPI) { if (wr == 1) PG8_BAR; }
    }
    PG8_WAIT_V(0);
    if constexpr (!ALIGN_EPI) { if (wr == 0) PG8_BAR; }
    PG8_BAR;
#undef PG8_SA
#undef PG8_SB
#undef PG8_STAGE
#undef PG8_LDA
#undef PG8_LDB
#undef PG8_MMA
#undef PG8_WAIT_V
#undef PG8_WAIT_L
#undef PG8_BAR
#undef PG8_SCHED
}
}

typedef const f32x4 (&AccRef)[2][2][4][2];

__device__ __forceinline__ u32x4 pack8(const f32x4 a, const f32x4 b) {
    u32x4 w; w.x = pk2(a[0], a[1]); w.y = pk2(a[2], a[3]); w.z = pk2(b[0], b[1]); w.w = pk2(b[2], b[3]); return w;
}
struct EpiIn {
    static constexpr bool PERM = true;
    float* raw; bf16_t* H; float* out; int l;
    __device__ __forceinline__ void operator()(AccRef acc, const pg8::Unit& u, int wr, int wc, int fr, int fq) const {
        const int pn = u.pn, lr0 = wr * 64 + fr, ct = wc * 32 + 8 * fq;
        const size_t grow0 = (size_t)u.pm * 256;
        if (pn < 4) {
#pragma unroll
            for (int ai = 0; ai < 2; ++ai)
#pragma unroll
                for (int m = 0; m < 4; ++m) { float* rp = raw + (grow0 + lr0 + ai * 128 + m * 16) * RAWW + pn * 256 + ct;
#pragma unroll
                    for (int bj = 0; bj < 2; ++bj) { *(f32x4*)(rp + bj * 128) = acc[ai][bj][m][0]; *(f32x4*)(rp + bj * 128 + 4) = acc[ai][bj][m][1]; } }
            return;
        }
        float* sb = nullptr; int sp = 0; int rsub = 0;
        const bool prompt = u.pm < 64;
        const size_t lrow = prompt ? ((size_t)l * MP + grow0) : ((size_t)l * MS + (grow0 - MP));
        if (pn == 6 || pn == 7) { sb = out + (prompt ? O_PDK : O_SDK) + lrow * 512 + (pn - 6) * 256; sp = 512; }
        else if (pn == 8 || pn == 9) { sb = out + (prompt ? O_PDV : O_SDV) + lrow * 512 + (pn - 8) * 256; sp = 512; }
        else if (pn >= 13) {
            const int g = pn >= 16 ? 1 : 0, gc = (pn - (g ? 16 : 13)) * 256;
            if (prompt) { if ((u.pm & 7) >= 6) { const size_t r = (size_t)(l * 8 + (u.pm >> 3)) * 512 + ((u.pm & 7) - 6) * 256; sb = out + (g ? O_PBV : O_PBK) + r * 768 + gc; sp = 768; } }
            else { sb = out + (g ? O_SBV : O_SBK) + lrow * 768 + gc; sp = 768; }
        }
        (void)rsub;
        const int hc = (pn - 4) * 256 + ct;
#pragma unroll
        for (int ai = 0; ai < 2; ++ai)
#pragma unroll
            for (int m = 0; m < 4; ++m) { const int lr = lr0 + ai * 128 + m * 16; bf16_t* hp = H + (grow0 + lr) * HWD + hc;
#pragma unroll
                for (int bj = 0; bj < 2; ++bj) { *(u32x4*)(hp + bj * 128) = pack8(acc[ai][bj][m][0], acc[ai][bj][m][1]);
                    if (sb) { float* p = sb + (size_t)lr * sp + bj * 128 + ct; *(f32x4*)p = acc[ai][bj][m][0]; *(f32x4*)(p + 4) = acc[ai][bj][m][1]; } } }
    }
};
struct EpiBf {
    static constexpr bool PERM = true;
    bf16_t* O; int ldc;
    __device__ __forceinline__ void operator()(AccRef acc, const pg8::Unit& u, int wr, int wc, int fr, int fq) const {
        const int ct = u.pn * 256 + wc * 32 + 8 * fq; const size_t row0 = (size_t)u.pm * 256 + wr * 64 + fr;
#pragma unroll
        for (int ai = 0; ai < 2; ++ai)
#pragma unroll
            for (int m = 0; m < 4; ++m) { bf16_t* rp = O + (row0 + ai * 128 + m * 16) * ldc + ct;
#pragma unroll
                for (int bj = 0; bj < 2; ++bj) *(u32x4*)(rp + bj * 128) = pack8(acc[ai][bj][m][0], acc[ai][bj][m][1]); }
    }
};
struct EpiRes {
    static constexpr bool PERM = true;
    float* Z; float* slab; const float* resP; const float* resS; const float* stats; const float* gam; const float* bet; int K;
    __device__ __forceinline__ void operator()(AccRef acc, const pg8::Unit& u, int wr, int wc, int fr, int fq) const {
        const int ct = u.pn * 256 + wc * 32 + 8 * fq; const size_t row0 = (size_t)u.pm * 256 + wr * 64 + fr;
        if (u.koff != 0) {
            const int ks = (K == DM) ? (u.koff >> 8) : (2 * (u.koff / (64 * 22)) + ((u.koff / 64) % 22 != 0 ? 1 : 0));
            float* sl = slab + (size_t)(ks - 1) * MS * DM - (size_t)MP * DM;
#pragma unroll
            for (int ai = 0; ai < 2; ++ai)
#pragma unroll
                for (int m = 0; m < 4; ++m) { const size_t off = (row0 + ai * 128 + m * 16) * DM + ct;
#pragma unroll
                    for (int bj = 0; bj < 2; ++bj) { *(f32x4*)(sl + off + bj * 128) = acc[ai][bj][m][0]; *(f32x4*)(sl + off + bj * 128 + 4) = acc[ai][bj][m][1]; } }
            return;
        }
        if (resP) {
            const float* rb = (u.pm < 64) ? resP : (resS - (size_t)MP * DM);
#pragma unroll
            for (int ai = 0; ai < 2; ++ai)
#pragma unroll
                for (int m = 0; m < 4; ++m) { const size_t off = (row0 + ai * 128 + m * 16) * DM + ct;
#pragma unroll
                    for (int bj = 0; bj < 2; ++bj) { const f32x4 r0 = *(const f32x4*)(rb + off + bj * 128), r1 = *(const f32x4*)(rb + off + bj * 128 + 4);
                        *(f32x4*)(Z + off + bj * 128) = r0 * ALPHA + acc[ai][bj][m][0]; *(f32x4*)(Z + off + bj * 128 + 4) = r1 * ALPHA + acc[ai][bj][m][1]; } }
            return;
        }
        f32x4 g0[2], g1[2], b0[2], b1[2];
#pragma unroll
        for (int bj = 0; bj < 2; ++bj) { g0[bj] = *(const f32x4*)(gam + ct + bj * 128) * ALPHA; g1[bj] = *(const f32x4*)(gam + ct + bj * 128 + 4) * ALPHA;
            b0[bj] = *(const f32x4*)(bet + ct + bj * 128) * ALPHA; b1[bj] = *(const f32x4*)(bet + ct + bj * 128 + 4) * ALPHA; }
#pragma unroll
        for (int ai = 0; ai < 2; ++ai)
#pragma unroll
            for (int m = 0; m < 4; ++m) { const size_t r = row0 + ai * 128 + m * 16; const size_t off = r * DM + ct;
                const float mu = stats[2 * r], rs = stats[2 * r + 1];
#pragma unroll
                for (int bj = 0; bj < 2; ++bj) { const f32x4 z0 = *(const f32x4*)(Z + off + bj * 128), z1 = *(const f32x4*)(Z + off + bj * 128 + 4);
                    *(f32x4*)(Z + off + bj * 128) = ((z0 - mu) * rs) * g0[bj] + b0[bj] + acc[ai][bj][m][0];
                    *(f32x4*)(Z + off + bj * 128 + 4) = ((z1 - mu) * rs) * g1[bj] + b1[bj] + acc[ai][bj][m][1]; } }
    }
};
template <int CTRL> __device__ __forceinline__ float dppf(float old, float src) {
    return __int_as_float(__builtin_amdgcn_update_dpp(__float_as_int(old), __float_as_int(src), CTRL, 0xf, 0xf, false));
}
__device__ __forceinline__ float silu_f(float x) { return x * __builtin_amdgcn_rcpf(1.f + __builtin_amdgcn_exp2f(-x * LOG2E)); }
struct EpiGU {
    static constexpr bool PERM = true;
    bf16_t* Hh; bf16_t* GH; bf16_t* UH; const float* cw; const float* cb;
    __device__ __forceinline__ void operator()(AccRef acc, const pg8::Unit& u, int wr, int wc, int fr, int fq) const {
        const int ffc = u.pn * 128 + wc * 32 + 8 * fq;
        float w0[8], w1[8], w2[8], bb[8];
        { const f32x4 a0 = *(const f32x4*)(cw + ffc), a1 = *(const f32x4*)(cw + ffc + 4), b0 = *(const f32x4*)(cw + DFF + ffc), b1 = *(const f32x4*)(cw + DFF + ffc + 4),
                      c0 = *(const f32x4*)(cw + 2 * DFF + ffc), c1 = *(const f32x4*)(cw + 2 * DFF + ffc + 4), d0 = *(const f32x4*)(cb + ffc), d1 = *(const f32x4*)(cb + ffc + 4);
#pragma unroll
          for (int e = 0; e < 4; ++e) { w0[e] = a0[e]; w0[4 + e] = a1[e]; w1[e] = b0[e]; w1[4 + e] = b1[e]; w2[e] = c0[e]; w2[4 + e] = c1[e]; bb[e] = d0[e]; bb[4 + e] = d1[e]; } }
#pragma unroll
        for (int ai = 0; ai < 2; ++ai) {
            const int slab = u.pm * 4 + ai * 2 + wr;
            float gp[8];
#pragma unroll
            for (int e = 0; e < 8; ++e) gp[e] = 0.f;
#pragma unroll
            for (int m = 0; m < 4; ++m) {
                float g[8], uu[8], h[8];
#pragma unroll
                for (int e = 0; e < 4; ++e) { g[e] = acc[ai][0][m][0][e]; g[4 + e] = acc[ai][0][m][1][e]; uu[e] = acc[ai][1][m][0][e]; uu[4 + e] = acc[ai][1][m][1][e]; }
#pragma unroll
                for (int e = 0; e < 8; ++e) {
                    const float p1 = dppf<0x111>(dppf<0x121>(0.f, gp[e]), g[e]);
                    const float p2 = dppf<0x112>(dppf<0x122>(0.f, gp[e]), g[e]);
                    h[e] = silu_f(bb[e] + w0[e] * p2 + w1[e] * p1 + w2[e] * g[e]) * uu[e];
                    gp[e] = g[e];
                }
                const int lr = m * 16 + fr; const size_t row = (size_t)slab * 64 + lr;
                u32x4 o; o.x = pk2(h[0], h[1]); o.y = pk2(h[2], h[3]); o.z = pk2(h[4], h[5]); o.w = pk2(h[6], h[7]);
                *(u32x4*)(Hh + row * DFF + ffc) = o;
                if (m == 0 || m == 3) {
                    u32x4 gb; gb.x = pk2(g[0], g[1]); gb.y = pk2(g[2], g[3]); gb.z = pk2(g[4], g[5]); gb.w = pk2(g[6], g[7]);
                    if (m == 3 && fr >= 14) *(u32x4*)(GH + ((size_t)slab * 4 + (fr - 14)) * DFF + ffc) = gb;
                    if (m == 0 && fr < 2) { *(u32x4*)(GH + ((size_t)slab * 4 + 2 + fr) * DFF + ffc) = gb;
                        u32x4 ub; ub.x = pk2(uu[0], uu[1]); ub.y = pk2(uu[2], uu[3]); ub.z = pk2(uu[4], uu[5]); ub.w = pk2(uu[6], uu[7]);
                        *(u32x4*)(UH + ((size_t)slab * 2 + fr) * DFF + ffc) = ub; }
                }
            }
        }
    }
};

struct Params { const float* in[31]; float* out; unsigned char* ws; };
typedef const __attribute__((address_space(4))) Params* KP;
__device__ __forceinline__ KP kparams() { KP k = (KP)__builtin_amdgcn_kernarg_segment_ptr(); asm volatile("" : "+s"(k)); return k; }
enum { I_XP = 0, I_XS, I_CCKV, I_CKR, I_CDK, I_CDV, I_CBK, I_CBV, I_CONV, I_T5, I_WIN, I_QN, I_WUQ, I_KVN, I_WUKV, I_LQ1, I_LK1, I_LQ2, I_LK2, I_SUBLN,
       I_BREL, I_WO, I_LN1G, I_LN1B, I_WG, I_WU, I_CW, I_CB, I_WD, I_LN2G, I_LN2B };

__device__ __forceinline__ void tconv(LAS unsigned char* lds, const float* W, int K, int Nsrc, bf16_t* Wt, int ndst, int map, const float* W2 = nullptr) {
    LAS float* tile = (LAS float*)lds;
    const int tid = opq(threadIdx.x), nbn = ndst / 256, nitems = nbn * (K / 64);
    for (int item = blockIdx.x; item < nitems; item += gridDim.x) {
        const int nb = item % nbn, kb = item / nbn, n0 = nb * 256;
        const int nn = tid & 255, k2 = tid >> 8; const int dn = n0 + nn;
        int sc = dn;
        if (map == 1) sc = dn < 832 ? dn : (dn < 1024 ? -1 : dn - 192);
        else if (map == 2) sc = dn < Nsrc ? dn : -1;
        else if (map == 3) sc = nb * 128 + (nn & 127);
        const float* wp = ((map == 3 && nn >= 128) ? W2 : W) + (size_t)(kb * 64 + k2) * Nsrc + (sc >= 0 ? sc : 0);
        float v[32];
#pragma unroll
        for (int i = 0; i < 32; ++i) v[i] = sc >= 0 ? wp[(size_t)(2 * i) * Nsrc] : 0.f;
#pragma unroll
        for (int i = 0; i < 32; ++i) tile[(k2 + 2 * i) * 257 + nn] = v[i];
        __syncthreads();
        const int kc = tid & 7;
#pragma unroll
        for (int j = 0; j < 4; ++j) { const int n = (tid >> 3) + 64 * j; const LAS float* s = tile + (kc * 8) * 257 + n;
            u32x4 o; o.x = pk2(s[0], s[257]); o.y = pk2(s[2 * 257], s[3 * 257]); o.z = pk2(s[4 * 257], s[5 * 257]); o.w = pk2(s[6 * 257], s[7 * 257]);
            *(u32x4*)(Wt + (size_t)(n0 + n) * K + kb * 64 + kc * 8) = o; }
        __syncthreads();
    }
}
__device__ __forceinline__ void convert_weights(LAS unsigned char* lds, KP p, int l) {
    unsigned char* ws = p->ws;
    tconv(lds, p->in[I_WIN] + (size_t)l * DM * 4672, DM, 4672, (bf16_t*)(ws + WS_WIN), NIN, 1);
    tconv(lds, p->in[I_WUQ] + (size_t)l * 512 * 1152, 512, 1152, (bf16_t*)(ws + WS_WUQ), NQ, 2);
    tconv(lds, p->in[I_WUKV] + (size_t)l * 256 * 1536, 256, 1536, (bf16_t*)(ws + WS_WUKV), NKVC, 0);
    tconv(lds, p->in[I_WO] + (size_t)l * DM * DM, DM, DM, (bf16_t*)(ws + WS_WO), DM, 0);
    tconv(lds, p->in[I_WG] + (size_t)l * DM * DFF, DM, DFF, (bf16_t*)(ws + WS_WGU), 2 * DFF, 3, p->in[I_WU] + (size_t)l * DM * DFF);
    tconv(lds, p->in[I_WD] + (size_t)l * DFF * DM, DFF, DM, (bf16_t*)(ws + WS_WD), DM, 0);
}
__device__ __forceinline__ void cvt_rows(const float* src, bf16_t* dst, int nb, int rpb, int w, int drpb) {
    const int w8 = w >> 3; const long total = (long)nb * rpb * w8; const long gt = (long)blockIdx.x * 512 + opq(threadIdx.x), gn = (long)gridDim.x * 512;
    for (long ch0 = gt; ch0 < total; ch0 += 4 * gn) {
        f32x4 a[4], c[4]; size_t doff[4]; bool ok[4];
#pragma unroll
        for (int u = 0; u < 4; ++u) { const long ch = ch0 + u * gn; ok[u] = ch < total; const long chc = ok[u] ? ch : ch0;
            const int cc = (int)(chc % w8); const long rj = chc / w8; const int b = (int)(rj / rpb), j = (int)(rj % rpb);
            a[u] = *(const f32x4*)(src + rj * w + cc * 8); c[u] = *(const f32x4*)(src + rj * w + cc * 8 + 4); doff[u] = ((size_t)b * drpb + j) * w + cc * 8; }
#pragma unroll
        for (int u = 0; u < 4; ++u) if (ok[u]) *(u32x4*)(dst + doff[u]) = pack8(a[u], c[u]);
    }
}
__device__ __forceinline__ int t5_bucket(int rel) {
    const int n = rel < 0 ? -rel : rel; int b;
    if (n < 8) b = n; else if (n < 12) b = 8; else if (n < 16) b = 9; else if (n < 23) b = 10; else if (n < 32) b = 11; else if (n < 46) b = 12; else if (n < 64) b = 13; else if (n < 91) b = 14; else b = 15;
    return (rel > 0 ? 16 : 0) + b;
}
__device__ __forceinline__ void prologue(LAS unsigned char* lds, KP p) {
    unsigned char* ws = p->ws;
    convert_weights(lds, p, 0);
    cvt_rows(p->in[I_XP], (bf16_t*)(ws + WS_XB), 1, MP, DM, MP);
    cvt_rows(p->in[I_XS], (bf16_t*)(ws + WS_XB) + (size_t)MP * DM, 1, MS, DM, MS);
    const long gt = (long)blockIdx.x * 512 + opq(threadIdx.x), gn = (long)gridDim.x * 512;
    float* rope = (float*)(ws + WS_ROPE);
    for (long i = gt; i < (long)SKV * 32; i += gn) { const int pos = (int)(i >> 5), j = (int)(i & 31);
        const float inv = powf(10000.0f, -(float)j / 32.0f); const float ang = (float)pos * inv; float s, c; sincosf(ang, &s, &c);
        rope[pos * 64 + j] = c; rope[pos * 64 + 32 + j] = s; }
    float* t5 = (float*)(ws + WS_T5);
    for (long i = gt; i < 4L * T5N; i += gn) { const int h = (int)(i / T5N), idx = (int)(i % T5N); const int rel = idx - T5OFF;
        t5[i] = p->in[I_T5][t5_bucket(rel) * 4 + h] * LOG2E; }
    if (blockIdx.x == 0 && threadIdx.x < 128) {
        const int l = threadIdx.x >> 6, j = threadIdx.x & 63;
        const float a = wave_sum(p->in[I_LQ1][l * 64 + j] * p->in[I_LK1][l * 64 + j]), b = wave_sum(p->in[I_LQ2][l * 64 + j] * p->in[I_LK2][l * 64 + j]);
        if (j == 0) ((float*)(ws + WS_LAM))[l] = expf(a) - expf(b) + (0.8f - 0.6f * expf(-0.3f * (float)l));
    }
}

__device__ __forceinline__ void post_in_phase(KP p, int l) {
    unsigned char* ws = p->ws;
    const int tidq = opq(threadIdx.x); const int lane = tidq & 63, gw = blockIdx.x * 8 + (tidq >> 6), ngw = gridDim.x * 8;
    const float* raw = (const float*)(ws + WS_RAW); const bf16_t* H = (const bf16_t*)(ws + WS_H);
    bf16_t* cqn = (bf16_t*)(ws + WS_CQN); bf16_t* ckva = (bf16_t*)(ws + WS_CKVA); bf16_t* kr = (bf16_t*)(ws + WS_KR);
    const float* rope = (const float*)(ws + WS_ROPE);
    const float* qg = p->in[I_QN] + l * 512; const float* kg = p->in[I_KVN] + l * 256;
    for (int r = gw; r < MT; r += ngw) {
        const float* rr = raw + (size_t)r * RAWW;
        const bool prompt = r < MP; const int rs = r - MP, b = rs >> 6, t = rs & 63;
        const size_t arow = prompt ? (size_t)r : (size_t)MP + (size_t)b * SKV + PAST + t;
        const int pos = prompt ? (r & (SEQ - 1)) : PAST + t;
        {
            const f32x4 a = *(const f32x4*)(rr + lane * 8), c = *(const f32x4*)(rr + lane * 8 + 4);
            float ss = a[0] * a[0] + a[1] * a[1] + a[2] * a[2] + a[3] * a[3] + c[0] * c[0] + c[1] * c[1] + c[2] * c[2] + c[3] * c[3];
            ss = wave_sum(ss); const float rs_ = rsqrtf(ss * (1.f / 512.f) + 1e-6f);
            const f32x4 g0 = *(const f32x4*)(qg + lane * 8), g1 = *(const f32x4*)(qg + lane * 8 + 4);
            *(u32x4*)(cqn + (size_t)r * 512 + lane * 8) = pack8(a * rs_ * g0, c * rs_ * g1);
        }
        {
            const f32x4 a = *(const f32x4*)(rr + 512 + lane * 4);
            float ss = wave_sum(a[0] * a[0] + a[1] * a[1] + a[2] * a[2] + a[3] * a[3]); const float rs_ = rsqrtf(ss * (1.f / 256.f) + 1e-6f);
            const f32x4 g0 = *(const f32x4*)(kg + lane * 4); const f32x4 v = a * rs_ * g0;
            float* op = prompt ? p->out + O_PCKV + ((size_t)l * MP + r) * 256 : p->out + O_SCKV + ((size_t)l * MS + rs) * 256;
            *(f32x4*)(op + lane * 4) = v;
            u32x2 w; w.x = pk2(v[0], v[1]); w.y = pk2(v[2], v[3]); *(u32x2*)(ckva + arow * 256 + lane * 4) = w;
        }
        if (lane < 32) {
            const float x1 = rr[768 + lane], x2 = rr[768 + 32 + lane]; const float c = rope[pos * 64 + lane], s = rope[pos * 64 + 32 + lane];
            const float y1 = x1 * c - x2 * s, y2 = x1 * s + x2 * c;
            float* op = prompt ? p->out + O_PKR + ((size_t)l * MP + r) * 64 : p->out + O_SKR + ((size_t)l * MS + rs) * 64;
            op[lane] = y1; op[32 + lane] = y2;
            kr[arow * 64 + lane] = (bf16_t)(pk2(y1, 0.f) & 0xffffu); kr[arow * 64 + 32 + lane] = (bf16_t)(pk2(y2, 0.f) & 0xffffu);
        }
    }
}

__device__ __forceinline__ void cvt_queue(LAS unsigned char* lds, KP p, int l) {
    unsigned char* ws = p->ws; const int tid = opq(threadIdx.x);
    unsigned* ctr = (unsigned*)(ws + WS_CTL) + 1024 + 64 * l;
    volatile LAS int* slot = (volatile LAS int*)(lds + 131072 + 512);
    for (;;) {
        if (tid == 0) slot[0] = (int)atomicAdd(ctr, 1u);
        __syncthreads();
        int c = slot[0];
        __syncthreads();
        if (c >= 640) break;
        const float* src; bf16_t* dst; int rpb, w, drpb;
        if (c < 512) { src = p->in[I_CCKV] + (size_t)l * NBS * PAST * 256; dst = (bf16_t*)(ws + WS_CKVA) + (size_t)MP * 256; rpb = PAST; w = 256; drpb = SKV; }
        else { c -= 512; src = p->in[I_CKR] + (size_t)l * NBS * PAST * 64; dst = (bf16_t*)(ws + WS_KR) + (size_t)MP * 64; rpb = PAST; w = 64; drpb = SKV; }
        const int w8 = w >> 3;
        f32x4 a[4], d[4]; size_t doff[4];
#pragma unroll
        for (int u = 0; u < 4; ++u) { const long ch = (long)c * 2048 + u * 512 + tid; const int cc = (int)(ch % w8); const long rj = ch / w8; const int b = (int)(rj / rpb), j = (int)(rj % rpb);
            a[u] = *(const f32x4*)(src + rj * w + cc * 8); d[u] = *(const f32x4*)(src + rj * w + cc * 8 + 4); doff[u] = ((size_t)b * drpb + j) * w + cc * 8; }
#pragma unroll
        for (int u = 0; u < 4; ++u) *(u32x4*)(dst + doff[u]) = pack8(a[u], d[u]);
    }
}

__device__ __forceinline__ void ln_load_row(float* Z, const float* slab, int r, int lane, f32x4 (&v)[8]) {
    float* zr = Z + (size_t)r * DM;
#pragma unroll
    for (int j = 0; j < 8; ++j) v[j] = *(const f32x4*)(zr + j * 256 + lane * 4);
    if (r >= MP) {
#pragma unroll 1
        for (int ks = 1; ks < 8; ++ks) { const float* sr = slab + ((size_t)(ks - 1) * MS + (r - MP)) * DM;
#pragma unroll
            for (int j = 0; j < 8; ++j) v[j] += *(const f32x4*)(sr + j * 256 + lane * 4); }
#pragma unroll
        for (int j = 0; j < 8; ++j) *(f32x4*)(zr + j * 256 + lane * 4) = v[j];
    }
}
__device__ __forceinline__ void ln_finish_row(int r, int lane, f32x4 (&v)[8], const float* g, const float* bta, float* stats, float* yout, bf16_t* xb) {
    float s = 0.f;
#pragma unroll
    for (int j = 0; j < 8; ++j) s += (v[j][0] + v[j][1]) + (v[j][2] + v[j][3]);
    const float mean = wave_sum(s) * (1.f / DM); float q = 0.f;
#pragma unroll
    for (int j = 0; j < 8; ++j) { v[j] = v[j] - mean; q += (v[j][0] * v[j][0] + v[j][1] * v[j][1]) + (v[j][2] * v[j][2] + v[j][3] * v[j][3]); }
    const float rstd = rsqrtf(wave_sum(q) * (1.f / DM) + 1e-5f);
    if (lane == 0) { stats[2 * r] = mean; stats[2 * r + 1] = rstd; }
#pragma unroll
    for (int j = 0; j < 8; ++j) { const int c = j * 256 + lane * 4; const f32x4 gg = *(const f32x4*)(g + c), bb = *(const f32x4*)(bta + c);
        const f32x4 y = v[j] * rstd * gg + bb; if (yout) *(f32x4*)(yout + (size_t)r * DM + c) = y;
        u32x2 w; w.x = pk2(y[0], y[1]); w.y = pk2(y[2], y[3]); *(u32x2*)(xb + (size_t)r * DM + c) = w; }
}
__device__ __forceinline__ void ln_phase(float* Z, const float* slab, const float* g, const float* bta, float* stats, float* yout, bf16_t* xb) {
    const int tidq = opq(threadIdx.x); const int lane = tidq & 63, gw = blockIdx.x * 8 + (tidq >> 6), ngw = gridDim.x * 8;
    f32x4 va[8], vb[8];
    int r = gw;
    if (r < MT) ln_load_row(Z, slab, r, lane, va);
    for (; r < MT; r += 2 * ngw) {
        const int r1 = r + ngw, r2 = r + 2 * ngw;
        if (r1 < MT) ln_load_row(Z, slab, r1, lane, vb);
        ln_finish_row(r, lane, va, g, bta, stats, yout, xb);
        if (r2 < MT) ln_load_row(Z, slab, r2, lane, va);
        if (r1 < MT) ln_finish_row(r1, lane, vb, g, bta, stats, yout, xb);
    }
}

__device__ __forceinline__ void unpack8(const u32x4 v, float (&f)[8]) {
#pragma unroll
    for (int e = 0; e < 4; ++e) { f[2 * e] = bflo(v[e]); f[2 * e + 1] = bfhi(v[e]); }
}
__device__ __forceinline__ void fixup_phase(KP p, int l) {
    unsigned char* ws = p->ws; bf16_t* Hh = (bf16_t*)(ws + WS_U); const bf16_t* GH = (const bf16_t*)(ws + WS_GH); const bf16_t* UH = (const bf16_t*)(ws + WS_UH);
    const float* cw = p->in[I_CW] + (size_t)l * 3 * DFF; const float* cb = p->in[I_CB] + (size_t)l * DFF; const float* st = p->in[I_CONV] + (size_t)l * NBS * 2 * DFF;
    constexpr int NCH = DFF / 8, NSLAB = MT / 64; const long total = (long)NSLAB * NCH; const long gt = (long)blockIdx.x * 512 + opq(threadIdx.x), gn = (long)gridDim.x * 512;
    for (long it = gt; it < total; it += gn) {
        const int cc = (int)(it % NCH), s = (int)(it / NCH), c0 = cc * 8; const bool prompt = s < MP / 64;
        float w0[8], w1[8], w2[8], bb[8], gm2[8], gm1[8], g0[8], g1[8], u0[8], u1[8], g62[8], g63[8];
#pragma unroll
        for (int e = 0; e < 8; ++e) { w0[e] = cw[c0 + e]; w1[e] = cw[DFF + c0 + e]; w2[e] = cw[2 * DFF + c0 + e]; bb[e] = cb[c0 + e]; }
        const bool first = prompt ? ((s & 31) == 0) : true;
        if (first) {
            if (prompt) {
#pragma unroll
                for (int e = 0; e < 8; ++e) { gm2[e] = 0.f; gm1[e] = 0.f; }
            } else { const int b = s - MP / 64;
#pragma unroll
                for (int e = 0; e < 8; ++e) { gm2[e] = st[((size_t)b * 2 + 0) * DFF + c0 + e]; gm1[e] = st[((size_t)b * 2 + 1) * DFF + c0 + e]; } }
        } else { unpack8(*(const u32x4*)(GH + ((size_t)(s - 1) * 4 + 0) * DFF + c0), gm2); unpack8(*(const u32x4*)(GH + ((size_t)(s - 1) * 4 + 1) * DFF + c0), gm1); }
        unpack8(*(const u32x4*)(GH + ((size_t)s * 4 + 2) * DFF + c0), g0); unpack8(*(const u32x4*)(GH + ((size_t)s * 4 + 3) * DFF + c0), g1);
        unpack8(*(const u32x4*)(UH + ((size_t)s * 2 + 0) * DFF + c0), u0); unpack8(*(const u32x4*)(UH + ((size_t)s * 2 + 1) * DFF + c0), u1);
        float h0[8], h1[8];
#pragma unroll
        for (int e = 0; e < 8; ++e) { h0[e] = silu_f(bb[e] + w0[e] * gm2[e] + w1[e] * gm1[e] + w2[e] * g0[e]) * u0[e]; h1[e] = silu_f(bb[e] + w0[e] * gm1[e] + w1[e] * g0[e] + w2[e] * g1[e]) * u1[e]; }
        u32x4 o; o.x = pk2(h0[0], h0[1]); o.y = pk2(h0[2], h0[3]); o.z = pk2(h0[4], h0[5]); o.w = pk2(h0[6], h0[7]);
        *(u32x4*)(Hh + (size_t)s * 64 * DFF + c0) = o;
        o.x = pk2(h1[0], h1[1]); o.y = pk2(h1[2], h1[3]); o.z = pk2(h1[4], h1[5]); o.w = pk2(h1[6], h1[7]);
        *(u32x4*)(Hh + ((size_t)s * 64 + 1) * DFF + c0) = o;
        const bool last = prompt ? ((s & 31) == 31) : true;
        if (last) {
            unpack8(*(const u32x4*)(GH + ((size_t)s * 4 + 0) * DFF + c0), g62); unpack8(*(const u32x4*)(GH + ((size_t)s * 4 + 1) * DFF + c0), g63);
            float* sp = prompt ? p->out + O_PCONV + ((size_t)(l * 8 + (s >> 5)) * 2) * DFF + c0 : p->out + O_SCONV + ((size_t)(l * 16 + (s - MP / 64)) * 2) * DFF + c0;
            *(f32x4*)sp = (f32x4){g62[0], g62[1], g62[2], g62[3]}; *(f32x4*)(sp + 4) = (f32x4){g62[4], g62[5], g62[6], g62[7]};
            *(f32x4*)(sp + DFF) = (f32x4){g63[0], g63[1], g63[2], g63[3]}; *(f32x4*)(sp + DFF + 4) = (f32x4){g63[4], g63[5], g63[6], g63[7]};
        }
    }
}

#define MFMA32(a, b, c) __builtin_amdgcn_mfma_f32_32x32x16_bf16((a), (b), (c), 0, 0, 0)
constexpr int A_VSTR = 136, A_VBUF = 128 * A_VSTR;
constexpr int A_KVEND = 2 * 64 * (192 + 8) * 2 + 2 * A_VBUF;
constexpr int A_STASH = 2 * 64 * (64 + 8) * 2 + 2 * A_VBUF;
constexpr int A_BIAS = 118784, A_WSF = A_BIAS + T5N * 4, A_UIDX = A_WSF + 8 * 64 * 4;
static_assert(A_STASH + 65536 <= A_BIAS && A_KVEND <= A_BIAS && A_UIDX + 64 <= 131072, "attention LDS");

struct AttnSrc {
    const bf16_t* K; int kpitch;
    const bf16_t* K2; int k2pitch;
    const bf16_t* V; int vpitch;
    int t0, t1;
    int lo_t, hi_t;
    bool wave_on;
    float scale2;
    int bias_base;
    const float* Kf; const float* Kf2; const float* Vf; const float* Vf2; int ntc;
    int qmin, kpos0;
};

template <int DQK, int BIAS, bool F32 = false>
__device__ __forceinline__ void attn_pass(LAS unsigned char* lds, const AttnSrc& a, const bf16x8 (&qf)[DQK / 16], f32x16 (&o)[4]) {
    constexpr int KSTR = (DQK + 8) * 2, NKCH = DQK / 8, NKI = DQK / 64, A_K0 = 0, A_K1 = 64 * KSTR, A_V0 = 2 * A_K1, A_V1 = A_V0 + A_VBUF;
    const int tid = opq(threadIdx.x), lane = tid & 63, r32 = lane & 31, hi = lane >> 5, wid = tid >> 6;
    const LAS float* bt = (const LAS float*)(lds + A_BIAS);
    volatile LAS float* wsf = (volatile LAS float*)(lds + A_WSF) + wid * 64;
    u32x4 kreg[F32 ? 1 : NKI]; u32x2 vreg[F32 ? 1 : 4];
    f32x4 kraw[F32 ? NKI : 1][2], vraw[F32 ? 4 : 1];
    const int vdq = tid & 31, vkq = tid >> 5;
    auto load_tile = [&](int t) {
        if constexpr (F32) {
            const float* kb_ = (t < a.ntc) ? a.Kf + (size_t)t * 64 * a.kpitch : a.Kf2; const float* vb_ = (t < a.ntc) ? a.Vf + (size_t)t * 64 * a.vpitch : a.Vf2;
#pragma unroll
            for (int i = 0; i < NKI; ++i) { const int c = tid + 512 * i, row = c / NKCH, cc = c % NKCH; const float* s_ = kb_ + (size_t)row * a.kpitch + cc * 8;
                kraw[i][0] = *(const f32x4*)s_; kraw[i][1] = *(const f32x4*)(s_ + 4); }
#pragma unroll
            for (int i = 0; i < 4; ++i) vraw[i] = *(const f32x4*)(vb_ + (size_t)(vkq * 4 + i) * a.vpitch + vdq * 4);
        } else {
            const size_t krow0 = (size_t)t * 64;
#pragma unroll
            for (int i = 0; i < NKI; ++i) { const int c = tid + 512 * i, row = c / NKCH, cc = c % NKCH;
                const bf16_t* src = (DQK == 192 && cc >= 16) ? a.K2 + (krow0 + row) * a.k2pitch + (cc - 16) * 8 : a.K + (krow0 + row) * a.kpitch + cc * 8;
                kreg[i] = *(const u32x4*)src; }
#pragma unroll
            for (int i = 0; i < 4; ++i) vreg[i] = *(const u32x2*)(a.V + (krow0 + vkq * 4 + i) * a.vpitch + vdq * 4);
        }
    };
    auto store_tile = [&](int buf) {
        LAS unsigned char* kb = lds + (buf ? A_K1 : A_K0); LAS unsigned char* vb = lds + (buf ? A_V1 : A_V0);
        u32x2 v0, v1, v2, v3;
        if constexpr (F32) {
#pragma unroll
            for (int i = 0; i < NKI; ++i) { const int c = tid + 512 * i, row = c / NKCH, cc = c % NKCH; *(LAS u32x4*)(kb + row * KSTR + cc * 16) = pack8(kraw[i][0], kraw[i][1]); }
            v0.x = pk2(vraw[0][0], vraw[0][1]); v0.y = pk2(vraw[0][2], vraw[0][3]); v1.x = pk2(vraw[1][0], vraw[1][1]); v1.y = pk2(vraw[1][2], vraw[1][3]);
            v2.x = pk2(vraw[2][0], vraw[2][1]); v2.y = pk2(vraw[2][2], vraw[2][3]); v3.x = pk2(vraw[3][0], vraw[3][1]); v3.y = pk2(vraw[3][2], vraw[3][3]);
        } else {
#pragma unroll
            for (int i = 0; i < NKI; ++i) { const int c = tid + 512 * i, row = c / NKCH, cc = c % NKCH; *(LAS u32x4*)(kb + row * KSTR + cc * 16) = kreg[i]; }
            v0 = vreg[0]; v1 = vreg[1]; v2 = vreg[2]; v3 = vreg[3];
        }
        u32x2 w0, w1, w2, w3;
        w0.x = (v0.x & 0xffffu) | (v1.x << 16); w0.y = (v2.x & 0xffffu) | (v3.x << 16);
        w1.x = (v0.x >> 16) | (v1.x & 0xffff0000u); w1.y = (v2.x >> 16) | (v3.x & 0xffff0000u);
        w2.x = (v0.y & 0xffffu) | (v1.y << 16); w2.y = (v2.y & 0xffffu) | (v3.y << 16);
        w3.x = (v0.y >> 16) | (v1.y & 0xffff0000u); w3.y = (v2.y >> 16) | (v3.y & 0xffff0000u);
        LAS unsigned char* vp = vb + (vdq * 4) * A_VSTR + (vkq >> 2) * 32 + (((vkq & 3) ^ ((vdq >> 2) & 3)) * 8);
        *(LAS u32x2*)(vp) = w0; *(LAS u32x2*)(vp + A_VSTR) = w1; *(LAS u32x2*)(vp + 2 * A_VSTR) = w2; *(LAS u32x2*)(vp + 3 * A_VSTR) = w3;
    };
    float m = -1e30f, l = 0.f;
#pragma unroll
    for (int d = 0; d < 4; ++d)
#pragma unroll
        for (int r = 0; r < 16; ++r) o[d][r] = 0.f;
    load_tile(a.t0); store_tile(0); __syncthreads();
    for (int t = a.t0; t < a.t1; ++t) {
        const int buf = (t - a.t0) & 1;
        if (t + 1 < a.t1) load_tile(t + 1);
        if (a.wave_on && t >= a.lo_t && t <= a.hi_t) {
#pragma unroll 1
            for (int half = 0; half < 2; ++half) {
                const LAS unsigned char* kb = lds + (buf ? A_K1 : A_K0) + (half * 32 + r32) * KSTR + hi * 16;
                f32x16 p0;
#pragma unroll
                for (int r = 0; r < 16; ++r) p0[r] = 0.f;
                constexpr int NF = DQK / 16, NBT = NF / 4;
                {
                    bf16x8 kf[2][4];
#pragma unroll
                    for (int j = 0; j < 4; ++j) kf[0][j] = *(const LAS bf16x8*)(kb + j * 32);
#pragma unroll
                    for (int bt = 0; bt < NBT; ++bt) {
                        if (bt + 1 < NBT) {
#pragma unroll
                            for (int j = 0; j < 4; ++j) kf[(bt + 1) & 1][j] = *(const LAS bf16x8*)(kb + ((bt + 1) * 4 + j) * 32);
                        }
                        __builtin_amdgcn_sched_barrier(0);
#pragma unroll
                        for (int j = 0; j < 4; ++j) p0 = MFMA32(kf[bt & 1][j], qf[bt * 4 + j], p0);
                        __builtin_amdgcn_sched_barrier(0);
                    }
                }
                const LAS unsigned char* vb = lds + (buf ? A_V1 : A_V0) + r32 * A_VSTR + ((hi ^ (r32 >> 4)) & 1) * 8 + half * 64;
                u32x4 vf[4][2];
#define RDV(d, ks) do { const u32x2 lo_ = *(const LAS u32x2*)(vb + (d) * 32 * A_VSTR + (ks) * 32 + (((d) & 1) ? 16 : 0)), h2_ = *(const LAS u32x2*)(vb + (d) * 32 * A_VSTR + (ks) * 32 + (((d) & 1) ? 0 : 16)); \
                        vf[d][ks].x = lo_.x; vf[d][ks].y = lo_.y; vf[d][ks].z = h2_.x; vf[d][ks].w = h2_.y; } while (0)
                if (DQK == 64) { RDV(0, 0); RDV(0, 1); }
                __builtin_amdgcn_sched_barrier(0);
                float mx = -1e30f;
                if (BIAS == 0) {
#pragma unroll
                    for (int r = 0; r < 16; ++r) { p0[r] *= a.scale2; mx = fmaxf(mx, p0[r]); }
                } else if (BIAS == 1) {
                    if (a.kpos0 + 64 * t + 63 <= a.qmin - 128) {
                        const float cbias = bt[T5OFF - 128];
#pragma unroll
                        for (int r = 0; r < 16; ++r) { p0[r] = p0[r] * a.scale2 + cbias; mx = fmaxf(mx, p0[r]); }
                    } else {
                        const LAS float* bp = bt + (a.bias_base + 64 * t + 32 * half);
#pragma unroll
                        for (int r = 0; r < 16; ++r) { const int ko = (r & 3) + 8 * (r >> 2); p0[r] = p0[r] * a.scale2 + bp[ko]; mx = fmaxf(mx, p0[r]); }
                    }
                } else {
                    if (a.qmin - (a.kpos0 + 64 * t + 63) >= 256) {
                        const float cbias = bt[512];
#pragma unroll
                        for (int r = 0; r < 16; ++r) { p0[r] = p0[r] * a.scale2 + cbias; mx = fmaxf(mx, p0[r]); }
                    } else {
                        const int jb = a.bias_base - 64 * t - 32 * half;
#pragma unroll
                        for (int r = 0; r < 16; ++r) { const int ko = (r & 3) + 8 * (r >> 2); const int i0 = min(jb - ko, 256) + 256;
                            p0[r] = p0[r] * a.scale2 + bt[i0]; mx = fmaxf(mx, p0[r]); }
                    }
                }
                mx = fmaxf(mx, __shfl_xor(mx, 32));
                const bool grow = mx > m + 8.0f;
                if (__any(grow)) {
                    const float mnew = grow ? mx : m, alpha = __builtin_amdgcn_exp2f(m - mnew); m = mnew; l *= alpha;
                    if (hi == 0) wsf[r32] = alpha;
#pragma unroll
                    for (int r = 0; r < 16; ++r) { const float f = wsf[crow(r, hi)];
#pragma unroll
                        for (int d = 0; d < 4; ++d) o[d][r] *= f; }
                }
                float rs = 0.f;
#pragma unroll
                for (int r = 0; r < 16; ++r) { p0[r] = __builtin_amdgcn_exp2f(p0[r] - m); rs += p0[r]; }
                l += rs;
                bf16x8 pa[2];
                { u32x4 w;
                  w.x = pk2(p0[0], p0[1]); w.y = pk2(p0[2], p0[3]); w.z = pk2(p0[4], p0[5]); w.w = pk2(p0[6], p0[7]); pa[0] = __builtin_bit_cast(bf16x8, w);
                  w.x = pk2(p0[8], p0[9]); w.y = pk2(p0[10], p0[11]); w.z = pk2(p0[12], p0[13]); w.w = pk2(p0[14], p0[15]); pa[1] = __builtin_bit_cast(bf16x8, w); }
                if (DQK != 64) { RDV(0, 0); RDV(0, 1); }
                RDV(1, 0); RDV(1, 1);
                __builtin_amdgcn_sched_barrier(0);
#pragma unroll
                for (int d = 0; d < 2; ++d)
#pragma unroll
                    for (int ks = 0; ks < 2; ++ks) o[d] = MFMA32(pa[ks], __builtin_bit_cast(bf16x8, vf[d][ks]), o[d]);
                RDV(2, 0); RDV(2, 1); RDV(3, 0); RDV(3, 1);
                __builtin_amdgcn_sched_barrier(0);
#pragma unroll
                for (int d = 2; d < 4; ++d)
#pragma unroll
                    for (int ks = 0; ks < 2; ++ks) o[d] = MFMA32(pa[ks], __builtin_bit_cast(bf16x8, vf[d][ks]), o[d]);
#undef RDV
            }
        }
        if (t + 1 < a.t1) store_tile(buf ^ 1);
        __syncthreads();
    }
    if (a.wave_on) {
        l += __shfl_xor(l, 32);
        if (hi == 0) wsf[r32] = 1.0f / l;
#pragma unroll
        for (int r = 0; r < 16; ++r) { const float f = wsf[crow(r, hi)];
#pragma unroll
            for (int d = 0; d < 4; ++d) o[d][r] *= f; }
    }
}

template <int NF>
__device__ __forceinline__ void load_q(bf16x8 (&qf)[NF], const bf16_t* qrow  ) {
#pragma unroll
    for (int d0 = 0; d0 < NF; ++d0) qf[d0] = *(const bf16x8*)(qrow + d0 * 16);
}
__device__ __forceinline__ void store_o(LAS unsigned char* stg, bf16_t* op  , const f32x16 (&o)[4], int lane) {
    const int r32 = lane & 31, hi = lane >> 5;
    LAS unsigned short* s = (LAS unsigned short*)stg + (4 * hi) * 128 + r32;
#pragma unroll
    for (int d = 0; d < 4; ++d)
#pragma unroll
        for (int r = 0; r < 16; ++r) s[((r & 3) + 8 * (r >> 2)) * 128 + d * 32] = (unsigned short)(pk2(o[d][r], 0.f) & 0xffffu);
    const int row = lane >> 4, ch = lane & 15;
    bf16_t* g = op + (size_t)row * DM + ch * 8;
#pragma unroll 1
    for (int i = 0; i < 8; ++i) { const u32x4 v = *(const LAS u32x4*)(stg + (i * 4 + row) * 256 + ch * 16); *(u32x4*)g = v; g += 4 * DM; }
}

__device__ __forceinline__ void attn_phase(LAS unsigned char* lds, KP p, int l, int rep = 0) {
    unsigned char* ws = p->ws;
    const int tid0 = opq(threadIdx.x);
    unsigned* ctr = (unsigned*)(ws + WS_CTL) + 64 * l + 128 * rep;
    volatile LAS int* uidx = (volatile LAS int*)(lds + A_UIDX);
    LAS float* bt = (LAS float*)(lds + A_BIAS);
    const bf16_t* Hb = (const bf16_t*)(ws + WS_H); const bf16_t* Qb = (const bf16_t*)(ws + WS_Q); const bf16_t* KVb = (const bf16_t*)(ws + WS_KV);
    const bf16_t* KRb = (const bf16_t*)(ws + WS_KR); bf16_t* Ob = (bf16_t*)(ws + WS_O);
    const float* rope = (const float*)(ws + WS_ROPE);
    for (;;) {
        const int tid = opq(tid0), lane = tid & 63, r32 = lane & 31, hi = lane >> 5, wid = tid >> 6;
        if (tid == 0) uidx[0] = (int)atomicAdd(ctr, 1u);
        __syncthreads();
        int idx = uidx[0];
        __syncthreads();
        if (idx >= 1280) break;
#ifdef PROBE_ATTN2
        if (rep == 1 && idx < 256) continue;
#endif
        bool sample; int b, hh, qb, type;
        if (idx < 256) { sample = true; b = idx >> 4; const int h16 = idx & 15; qb = 0; if (h16 < 6) { type = 0; hh = h16; } else if (h16 < 10) { type = 1; hh = h16 - 6; } else { type = 2; hh = h16 - 10; } }
        else { sample = false; idx -= 256;
            if (idx < 400) { qb = 7 - idx / 80; const int r = idx % 80; b = r / 10; const int h10 = r % 10; if (h10 < 6) { type = 0; hh = h10; } else { type = 1; hh = h10 - 6; } }
            else if (idx < 784) { idx -= 400; qb = 7 - idx / 48; const int r = idx % 48; b = r / 6; hh = r % 6; type = 2; }
            else { idx -= 784; qb = 2 - idx / 80; const int r = idx % 80; b = r / 10; const int h10 = r % 10; if (h10 < 6) { type = 0; hh = h10; } else { type = 1; hh = h10 - 6; } } }
        const size_t qrow0 = sample ? (size_t)MP + b * 64 : (size_t)b * SEQ + qb * 256;
        const int qpos = (sample ? PAST : qb * 256) + wid * 32 + r32;
        const size_t myrow = qrow0 + wid * 32 + r32;
        AttnSrc a;
        a.Kf = nullptr; a.Kf2 = nullptr; a.Vf = nullptr; a.Vf2 = nullptr; a.ntc = 0;
        a.qmin = __builtin_amdgcn_readfirstlane((sample ? PAST : qb * 256) + wid * 32); a.kpos0 = 0;
        a.wave_on = sample ? (wid < 2) : true;
        const int cq = sample ? 0 : 4 * qb + (wid >> 1);
        f32x16 o[4];
        bf16_t* op = Ob + (qrow0 + wid * 32) * DM;
        if (type == 0) {
            const size_t kvrow0 = sample ? (size_t)MP + (size_t)b * SKV : (size_t)b * SEQ;
            a.K = KVb + kvrow0 * NKVC + hh * 256; a.kpitch = NKVC; a.K2 = KRb + kvrow0 * 64; a.k2pitch = 64; a.V = KVb + kvrow0 * NKVC + hh * 256 + 128; a.vpitch = NKVC;
            a.t0 = 0; a.t1 = sample ? 33 : 4 * qb + 4; a.lo_t = 0; a.hi_t = sample ? 32 : cq; a.scale2 = 0.07216878364870322f * LOG2E; a.bias_base = 0;
            bf16x8 qf[12];
            if (a.wave_on) {
                load_q<12>(qf, Qb + myrow * NQ + hh * 192 + hi * 8);
                const float* rp = rope + (size_t)qpos * 64;
#pragma unroll
                for (int d0 = 8; d0 < 10; ++d0) { bf16x8 x1 = qf[d0], x2 = qf[d0 + 2]; u32x4 y1, y2; const u32x4 u1 = __builtin_bit_cast(u32x4, x1), u2 = __builtin_bit_cast(u32x4, x2);
#pragma unroll
                    for (int e = 0; e < 4; ++e) { const int i = 16 * (d0 - 8) + 8 * hi + 2 * e; const float c0 = rp[i], s0 = rp[32 + i], c1 = rp[i + 1], s1 = rp[33 + i];
                        const float a0 = bflo(u1[e]), a1 = bfhi(u1[e]), b0 = bflo(u2[e]), b1 = bfhi(u2[e]);
                        y1[e] = pk2(a0 * c0 - b0 * s0, a1 * c1 - b1 * s1); y2[e] = pk2(a0 * s0 + b0 * c0, a1 * s1 + b1 * c1); }
                    qf[d0] = __builtin_bit_cast(bf16x8, y1); qf[d0 + 2] = __builtin_bit_cast(bf16x8, y2); }
            } else {
#pragma unroll
                for (int d0 = 0; d0 < 12; ++d0) qf[d0] = (bf16x8){0, 0, 0, 0, 0, 0, 0, 0};
            }
            attn_pass<192, 0>(lds, a, qf, o);
            if (a.wave_on) store_o(lds + wid * 8192, op + hh * 128, o, lane);
        } else if (type == 1) {
            const float* t5 = (const float*)(ws + WS_T5) + hh * T5N;
            for (int i = tid; i < T5N; i += 512) bt[i] = t5[i];
            const float lam = ((const float*)(ws + WS_LAM))[l]; const float lam_init = 0.8f - 0.6f * expf(-0.3f * (float)l);
            const bf16_t* kbase; const bf16_t* vbase; int pitch;
            if (sample) { kbase = nullptr; vbase = nullptr; pitch = 512; a.ntc = 32;
                a.Kf = p->in[I_CDK] + ((size_t)(l * NBS + b) * PAST) * 512 + hh * 128; a.Kf2 = p->out + O_SDK + ((size_t)(l * NBS + b) * DSEQ) * 512 + hh * 128;
                a.Vf = p->in[I_CDV] + ((size_t)(l * NBS + b) * PAST) * 512 + hh * 128; a.Vf2 = p->out + O_SDV + ((size_t)(l * NBS + b) * DSEQ) * 512 + hh * 128; }
            else { kbase = Hb + (size_t)b * SEQ * HWD + 512 + hh * 128; vbase = Hb + (size_t)b * SEQ * HWD + 1024 + hh * 128; pitch = HWD; }
            a.kpitch = pitch; a.K2 = nullptr; a.k2pitch = 0; a.V = vbase; a.vpitch = pitch;
            a.t0 = 0; a.t1 = sample ? 33 : 4 * qb + 4; a.lo_t = 0; a.hi_t = sample ? 32 : cq; a.scale2 = 0.125f * LOG2E; a.bias_base = 4 * hi - qpos + T5OFF;
            for (int c = 0; c < 2; ++c) {
                a.K = kbase + c * 64; const float* kf0 = a.Kf; const float* kf20 = a.Kf2; if (sample) { a.Kf = kf0 + c * 64; a.Kf2 = kf20 + c * 64; }
                bf16x8 qf[4];
                if (a.wave_on) load_q<4>(qf, Hb + myrow * HWD + hh * 128 + c * 64 + hi * 8);
                else {
#pragma unroll
                    for (int d0 = 0; d0 < 4; ++d0) qf[d0] = (bf16x8){0, 0, 0, 0, 0, 0, 0, 0};
                }
                if (sample) { attn_pass<64, 1, true>(lds, a, qf, o); a.Kf = kf0; a.Kf2 = kf20; } else attn_pass<64, 1>(lds, a, qf, o);
                if (c == 0 && a.wave_on) { LAS unsigned* st = (LAS unsigned*)(lds + A_STASH + wid * 8192) + lane;
#pragma unroll
                    for (int d = 0; d < 4; ++d)
#pragma unroll
                        for (int e = 0; e < 8; ++e) st[(d * 8 + e) * 64] = pk2(o[d][2 * e], o[d][2 * e + 1]); }
            }
            if (a.wave_on) {
                float ss[16];
#pragma unroll
                for (int r = 0; r < 16; ++r) ss[r] = 0.f;
#pragma unroll
                for (int d = 0; d < 4; ++d)
#pragma unroll
                    for (int e = 0; e < 8; ++e) { const unsigned sv = ((const LAS unsigned*)(lds + A_STASH + wid * 8192))[(d * 8 + e) * 64 + lane]; const float v0 = bflo(sv) - lam * o[d][2 * e], v1 = bfhi(sv) - lam * o[d][2 * e + 1]; o[d][2 * e] = v0; o[d][2 * e + 1] = v1; ss[2 * e] += v0 * v0; ss[2 * e + 1] += v1 * v1; }
#pragma unroll
                for (int r = 0; r < 16; ++r) {
#pragma unroll
                    for (int off = 1; off < 32; off <<= 1) ss[r] += __shfl_xor(ss[r], off);
                    ss[r] = rsqrtf(ss[r] * (1.f / 128.f) + 1e-6f) * (1.f - lam_init);
                }
                const float* sg = p->in[I_SUBLN] + l * 128;
#pragma unroll
                for (int d = 0; d < 4; ++d) { const float g = sg[d * 32 + r32];
#pragma unroll
                    for (int r = 0; r < 16; ++r) o[d][r] *= ss[r] * g; }
                store_o(lds + A_STASH + wid * 8192, op + 768 + hh * 128, o, lane);
            }
        } else {
            const float* br = p->in[I_BREL] + ((size_t)l * 6 + hh) * 513;
            for (int i = tid; i < 513; i += 512) bt[i] = br[i] * LOG2E;
            int kpos0;
            if (sample) { a.K = nullptr; a.V = nullptr; a.kpitch = 768; a.vpitch = 768; a.ntc = 8;
                a.Kf = p->in[I_CBK] + ((size_t)(l * NBS + b) * 512) * 768 + hh * 128; a.Kf2 = p->out + O_SBK + ((size_t)(l * NBS + b) * DSEQ) * 768 + hh * 128;
                a.Vf = p->in[I_CBV] + ((size_t)(l * NBS + b) * 512) * 768 + hh * 128; a.Vf2 = p->out + O_SBV + ((size_t)(l * NBS + b) * DSEQ) * 768 + hh * 128;
                a.t0 = 0; a.t1 = 9; a.lo_t = 0; a.hi_t = 8; kpos0 = PAST - 512; a.kpos0 = PAST - 512; }
            else { a.K = Hb + (size_t)b * SEQ * HWD + 2304 + hh * 128; a.V = Hb + (size_t)b * SEQ * HWD + 3072 + hh * 128; a.kpitch = HWD; a.vpitch = HWD;
                a.t0 = max(0, 4 * qb - 8); a.t1 = 4 * qb + 4; a.lo_t = cq - 8; a.hi_t = cq; kpos0 = 0; }
            a.K2 = nullptr; a.k2pitch = 0; a.scale2 = 0.08838834764831845f * LOG2E; a.bias_base = qpos - kpos0 - 4 * hi;
            bf16x8 qf[8];
            if (a.wave_on) load_q<8>(qf, Hb + myrow * HWD + 1536 + hh * 128 + hi * 8);
            else {
#pragma unroll
                for (int d0 = 0; d0 < 8; ++d0) qf[d0] = (bf16x8){0, 0, 0, 0, 0, 0, 0, 0};
            }
            if (sample) attn_pass<128, 2, true>(lds, a, qf, o); else attn_pass<128, 2>(lds, a, qf, o);
            if (a.wave_on) store_o(lds + wid * 8192, op + 1280 + hh * 128, o, lane);
        }
        __syncthreads();
    }
}


#define XB_TMO      128
#define XB_XCNT(j)  (256  + 64 * (j))
#define XB_XSUB(j)  (1280 + 64 * (j))
#define XB_XGEN(j)  (2304 + 64 * (j))
#define XB_TOP      3328
#define XB_TOPGEN   3392
#define XCD_BAR_WORDS 3456
#define XB_SPIN_CAP (1u << 22)
__device__ __forceinline__ unsigned xb_ld(unsigned* p)              { return __hip_atomic_load(p, __ATOMIC_RELAXED, __HIP_MEMORY_SCOPE_AGENT); }
__device__ __forceinline__ unsigned xb_add(unsigned* p, unsigned v) { return __hip_atomic_fetch_add(p, v, __ATOMIC_RELAXED, __HIP_MEMORY_SCOPE_AGENT); }
__device__ __forceinline__ unsigned xb_xcc_id() { return (unsigned)__builtin_amdgcn_s_getreg((3 << 11) | 20) & 0xFu; }
#define XB_SPIN(cond, bar) do { unsigned _sp = 0; while (cond) { __builtin_amdgcn_s_sleep(1); \
    if ((++_sp & 255u) == 0u) { if (xb_ld(&(bar)[XB_TMO])) break; if (_sp > XB_SPIN_CAP) { atomicAdd(&(bar)[XB_TMO], 1u); break; } } } } while (0)
struct XcdBarrier { unsigned* bar; unsigned x; volatile LAS unsigned* st; };
__device__ __forceinline__ XcdBarrier xcd_barrier_post(unsigned* bar, volatile LAS unsigned* st) {
    XcdBarrier b; b.bar = bar; b.x = xb_xcc_id(); b.st = st;
    if (threadIdx.x == 0) (void)xb_add(&bar[XB_XCNT(b.x)], 1u);
    return b;
}
__device__ __forceinline__ void xcd_barrier_complete(unsigned* bar, unsigned x, unsigned& nloc, unsigned& nx) {
    const unsigned G = gridDim.x * gridDim.y * gridDim.z;
    unsigned sum, cnt, mine, sp = 0u;
    for (;;) {
        sum = 0u; cnt = 0u; mine = 0u;
#pragma unroll
        for (unsigned j = 0; j < 16; ++j) { const unsigned c = xb_ld(&bar[XB_XCNT(j)]); sum += c; cnt += (c > 0u) ? 1u : 0u; mine = (j == x) ? c : mine; }
        if (sum == G) break;
        __builtin_amdgcn_s_sleep(1);
        if ((++sp & 255u) == 0u) { if (xb_ld(&bar[XB_TMO])) break; if (sp > XB_SPIN_CAP) { atomicAdd(&bar[XB_TMO], 1u); break; } }
    }
    nloc = mine > 0u ? mine : 1u; nx = cnt > 0u ? cnt : 1u;
}
__device__ __forceinline__ void xcd_barrier(const XcdBarrier& b) {
    asm volatile("s_waitcnt vmcnt(0)" ::: "memory");
    __syncthreads();
    if (threadIdx.x == 0) {
        unsigned* bar = b.bar;
        __builtin_amdgcn_s_waitcnt(0);
        unsigned nloc = b.st[0], nx = b.st[1];
        if (nloc == 0u) { xcd_barrier_complete(bar, b.x, nloc, nx); b.st[0] = nloc; b.st[1] = nx; }
        const unsigned old = xb_add(&bar[XB_XSUB(b.x)], 1u);
        const unsigned gen = old / nloc;
        if (old + 1u == (gen + 1u) * nloc) {
            __builtin_amdgcn_fence(__ATOMIC_RELEASE, "agent");
            asm volatile("s_waitcnt vmcnt(0)" ::: "memory");
            const unsigned og = xb_add(&bar[XB_TOP], 1u);
            const unsigned tg = og / nx;
            if (og + 1u == (tg + 1u) * nx) xb_add(&bar[XB_TOPGEN], 1u);
            else XB_SPIN(xb_ld(&bar[XB_TOPGEN]) == tg, bar);
            __builtin_amdgcn_fence(__ATOMIC_ACQUIRE, "agent");
            xb_add(&bar[XB_XGEN(b.x)], 1u);
            asm volatile("s_waitcnt vmcnt(0)" ::: "memory");
        } else {
            XB_SPIN(xb_ld(&bar[XB_XGEN(b.x)]) == gen, bar);
            __builtin_amdgcn_fence(__ATOMIC_ACQUIRE, "agent");
            asm volatile("s_waitcnt vmcnt(0)" ::: "memory");
        }
    }
    __syncthreads();
}

__device__ __forceinline__ unsigned char* lws(unsigned char* q) { asm volatile("" : "+s"(q)); return q; }
__global__ void __launch_bounds__(512, 2) fwd_kernel(Params p) {
    extern __shared__ __attribute__((aligned(16))) unsigned char lds_raw[];
    LAS unsigned char* lds0 = (LAS unsigned char*)lds_raw;
    LAS unsigned char* lds = lds0; asm volatile("" : "+s"(lds));
    cg::grid_group grid = cg::this_grid();
    volatile LAS unsigned* bst = (volatile LAS unsigned*)(lds + 131072 + 320);
    if (threadIdx.x < 2) bst[threadIdx.x] = 0u;
    __syncthreads();
    const XcdBarrier xbar = xcd_barrier_post((unsigned*)(kparams()->ws + WS_BAR), bst);
#ifndef NO_PRO
    prologue(lds, kparams());
#endif
#ifdef PROBE_PRO2
    __syncthreads(); prologue(lds, kparams());
#endif
    grid.sync();
#pragma unroll 1
    for (int ph = 0; ph < 20; ++ph) {
        const int l = opqs(ph / 10), s = opqs(ph % 10);
        KP kp = kparams();
        LAS unsigned char* lds = lds0; asm volatile("" : "+s"(lds));
        unsigned char* ws = lws(kp->ws);
        const int G = opss(gridDim.x), bx = opss(blockIdx.x);
        if (s == 0) {
#ifndef NO_G1
            pg8::Gemm g{(const bf16_t*)(ws + WS_XB), (const bf16_t*)(ws + WS_WIN), MT, NIN, DM}; pg8::StaticOrder S; S.init(MT, NIN, DM, G, bx);
            EpiIn E{(float*)(ws + WS_RAW), (bf16_t*)(ws + WS_H), kp->out, l};
            pg8::gemm_phase<EpiIn, pg8::StaticOrder, true, true>(lds, g, S, E);
            cvt_queue(lds, kparams(), l);
#ifdef PROBE_GEMMS2
            __syncthreads(); pg8::gemm_phase<EpiIn, pg8::StaticOrder, true, true>(lds, g, S, E);
#endif
#endif
        } else if (s == 1) {
#ifndef NO_POST
            post_in_phase(kp, l);
#ifdef PROBE_POST2
            post_in_phase(kparams(), l);
#endif
#endif
        } else if (s == 2) {
#ifndef NO_G2
            { pg8::Gemm g{(const bf16_t*)(ws + WS_CQN), (const bf16_t*)(ws + WS_WUQ), MT, NQ, 512}; pg8::StaticOrder S; S.init(MT, NQ, 512, G, bx);
              EpiBf E{(bf16_t*)(ws + WS_Q), NQ};
              pg8::gemm_phase<EpiBf, pg8::StaticOrder, true, true>(lds, g, S, E);
#ifdef PROBE_GEMMS2
              __syncthreads(); pg8::gemm_phase<EpiBf, pg8::StaticOrder, true, true>(lds, g, S, E);
#endif
              }
            { unsigned char* ws2 = lws(kp->ws); const int G2 = opss(gridDim.x), bx2 = opss(blockIdx.x);
              pg8::Gemm g2{(const bf16_t*)(ws2 + WS_CKVA), (const bf16_t*)(ws2 + WS_WUKV), MKV, NKVC, 256}; pg8::StaticOrder S2; S2.init(MKV, NKVC, 256, G2, bx2);
              EpiBf E2{(bf16_t*)(ws2 + WS_KV), NKVC};
              pg8::gemm_phase<EpiBf, pg8::StaticOrder, true, true>(lds, g2, S2, E2);
#ifdef PROBE_GEMMS2
              __syncthreads(); pg8::gemm_phase<EpiBf, pg8::StaticOrder, true, true>(lds, g2, S2, E2);
#endif
              }
#endif
        } else if (s == 3) {
#ifndef NO_ATTN
            attn_phase(lds, kp, l);
#ifdef PROBE_ATTN2
            __syncthreads(); attn_phase(lds, kparams(), l, 1);
#endif
#endif
        } else if (s == 4) {
#ifndef NO_G3
            pg8::Gemm g{(const bf16_t*)(ws + WS_O), (const bf16_t*)(ws + WS_WO), MT, DM, DM}; pg8::TailOrder S; S.init(DM, G, bx);
            EpiRes E{(float*)(ws + WS_Z), (float*)(ws + WS_SLAB), l == 0 ? kp->in[I_XP] : nullptr, l == 0 ? kp->in[I_XS] : nullptr, (const float*)(ws + WS_STATS),
                     kp->in[I_LN2G] + (l - 1) * DM, kp->in[I_LN2B] + (l - 1) * DM, DM};
            pg8::gemm_phase<EpiRes, pg8::TailOrder, true, true>(lds, g, S, E);
#ifdef PROBE_GEMMS2
            __syncthreads(); pg8::gemm_phase<EpiRes, pg8::TailOrder, true, true>(lds, g, S, E);
#endif
#endif
        } else if (s == 5) {
            ln_phase((float*)(ws + WS_Z), (const float*)(ws + WS_SLAB), kp->in[I_LN1G] + l * DM, kp->in[I_LN1B] + l * DM, (float*)(ws + WS_STATS), nullptr, (bf16_t*)(ws + WS_XB));
#ifdef PROBE_LN2
            ln_phase((float*)(ws + WS_Z), (const float*)(ws + WS_SLAB), kp->in[I_LN1G] + l * DM, kp->in[I_LN1B] + l * DM, (float*)(ws + WS_STATS), nullptr, (bf16_t*)(ws + WS_XB));
#endif
        } else if (s == 6) {
#ifndef NO_G4
            pg8::Gemm g{(const bf16_t*)(ws + WS_XB), (const bf16_t*)(ws + WS_WGU), MT, 2 * DFF, DM}; pg8::StaticOrder S; S.init(MT, 2 * DFF, DM, G, bx);
            EpiGU E{(bf16_t*)(ws + WS_U), (bf16_t*)(ws + WS_GH), (bf16_t*)(ws + WS_UH), kp->in[I_CW] + (size_t)l * 3 * DFF, kp->in[I_CB] + (size_t)l * DFF};
            pg8::gemm_phase<EpiGU, pg8::StaticOrder, true, true>(lds, g, S, E);
#ifdef PROBE_G42
            __syncthreads(); pg8::gemm_phase<EpiGU, pg8::StaticOrder, true, true>(lds, g, S, E);
#endif
#endif
        } else if (s == 7) {
#ifndef NO_CONV
            fixup_phase(kp, l);
#endif
        } else if (s == 8) {
#ifndef NO_G5
            pg8::Gemm g{(const bf16_t*)(ws + WS_U), (const bf16_t*)(ws + WS_WD), MT, DM, DFF}; pg8::TailOrder S; S.init(DFF, G, bx);
            EpiRes E{(float*)(ws + WS_Z), (float*)(ws + WS_SLAB), nullptr, nullptr, (const float*)(ws + WS_STATS), kp->in[I_LN1G] + l * DM, kp->in[I_LN1B] + l * DM, DFF};
            pg8::gemm_phase<EpiRes, pg8::TailOrder, true, true>(lds, g, S, E);
#ifdef PROBE_GEMMS2
            __syncthreads(); pg8::gemm_phase<EpiRes, pg8::TailOrder, true, true>(lds, g, S, E);
#endif
#endif
        } else {
            ln_phase((float*)(ws + WS_Z), (const float*)(ws + WS_SLAB), kp->in[I_LN2G] + l * DM, kp->in[I_LN2B] + l * DM, (float*)(ws + WS_STATS), l == 1 ? kp->out : nullptr, (bf16_t*)(ws + WS_XB));
#ifdef PROBE_LN2
            ln_phase((float*)(ws + WS_Z), (const float*)(ws + WS_SLAB), kp->in[I_LN2G] + l * DM, kp->in[I_LN2B] + l * DM, (float*)(ws + WS_STATS), l == 1 ? kp->out : nullptr, (bf16_t*)(ws + WS_XB));
#endif
            if (l == 0) { __syncthreads(); convert_weights(lds, kp, 1); }
        }
        if (ph == 19) break;
#ifdef USE_CG_SYNC
        grid.sync();
#else
        xcd_barrier(xbar);
#endif
#ifdef PROBE_BAR
        xcd_barrier(xbar);
#endif
    }
}

extern "C" void kernel_launch(void* const* d_in, const int* in_sizes, int n_in, void* d_out, int out_size, void* d_ws, size_t ws_size, hipStream_t stream) {
    static int grid_blocks = 0;
    if (grid_blocks == 0) {
        if (n_in != 31 || (size_t)out_size != O_END || ws_size < WS_END) { fprintf(stderr, "kernel_launch: unexpected shapes n_in %d out %d (want %zu) ws %zu (need %zu)\n", n_in, out_size, (size_t)O_END, ws_size, (size_t)WS_END); grid_blocks = -1; return; }
        int dev = 0, cus = 0, per_cu = 0;
        (void)hipGetDevice(&dev); (void)hipDeviceGetAttribute(&cus, hipDeviceAttributeMultiprocessorCount, dev);
        if (hipFuncSetAttribute((const void*)fwd_kernel, hipFuncAttributeMaxDynamicSharedMemorySize, LDS_BYTES) != hipSuccess) { fprintf(stderr, "kernel_launch: hipFuncSetAttribute failed\n"); grid_blocks = -1; return; }
        if (hipOccupancyMaxActiveBlocksPerMultiprocessor(&per_cu, (const void*)fwd_kernel, 512, LDS_BYTES) != hipSuccess || per_cu < 1) per_cu = 1;
        (void)hipGetLastError();
        grid_blocks = cus * (per_cu > 1 ? 1 : per_cu);
    }
    if (grid_blocks < 0) return;
    (void)hipMemsetAsync((char*)d_ws + WS_CTL, 0, CTL_BYTES, stream);
    Params p{};
    for (int i = 0; i < 31; ++i) p.in[i] = (const float*)d_in[i];
    p.out = (float*)d_out; p.ws = (unsigned char*)d_ws;
    void* args[] = {&p};
    hipError_t e = hipLaunchCooperativeKernel((const void*)fwd_kernel, dim3(grid_blocks), dim3(512), args, LDS_BYTES, stream);
    if (e != hipSuccess) fprintf(stderr, "cooperative launch failed: %s (grid %d)\n", hipGetErrorString(e), grid_blocks);
}
```
